# Optimizing an MI355X kernel written in HIP

```python
import numpy as np
import jax
import jax.numpy as jnp
from jax import lax

D_MODEL = 1024
BATCH = 4
SEQ = 4096
DEPTH = 4
DEC_BATCH = 16
DEC_SEQ = 4096
PAST_LEN = 128

N_MIXERS = 4
BRANCH = 1024
PLE_DIM = 256
GRID_W = 64
EPS = 1e-6

FN_GROUPS = 8
FN_GDIM = BRANCH // FN_GROUPS

NA_HEADS = 32
NA_HDIM = BRANCH // NA_HEADS
NA_KH_MAX = 8
NA_KW = 16
NA_QCB = 16
NA_KCB = 32

MLA_HEADS = 8
MLA_NOPE = 128
MLA_ROPE = 64
MLA_V = BRANCH // MLA_HEADS
MLA_Q_LORA = 384
MLA_KV_LORA = 256
MLA_QBLOCK = 128
ROPE_THETA = 10000.0

HG_EXPAND = 128
HG_HEADS = BRANCH // HG_EXPAND
HG_DV = BRANCH // HG_HEADS
HG_CHUNK = 64

kernel_name = "hybrid_bidir_fnet_natten_mla_hgrn2"


def rmsnorm(x, g):
    xf = x.astype(jnp.float32)
    y = xf * lax.rsqrt(jnp.mean(xf * xf, axis=-1, keepdims=True) + EPS)
    return (y * g.astype(jnp.float32)).astype(x.dtype)


def fourier_mixer(h, w_in, w_mix, w_out):
    b, s, _ = h.shape
    u, z = jnp.split(h @ w_in, 2, axis=-1)
    u = u.reshape(b, s, FN_GROUPS, FN_GDIM).astype(jnp.float32)
    f = jnp.fft.fft2(u, axes=(1, 3), norm="ortho").real.astype(h.dtype)
    y = jnp.einsum('bsgc,gcd->bsgd', f, w_mix).reshape(b, s, BRANCH)
    return (y * jax.nn.silu(z)) @ w_out


def na_tables(rows):
    kh = min(NA_KH_MAX, rows)
    r = np.arange(rows)
    row_start = np.clip(r - kh // 2, 0, rows - kh)
    row_off = row_start[:, None] + np.arange(kh)[None, :] - r[:, None] + (NA_KH_MAX - 1)
    ncb = GRID_W // NA_QCB
    j = np.arange(ncb)
    kc_start = np.clip(j * NA_QCB - NA_KW // 2, 0, GRID_W - NA_KCB)
    qcol = j[:, None] * NA_QCB + np.arange(NA_QCB)[None, :]
    kcol = kc_start[:, None] + np.arange(NA_KCB)[None, :]
    win = np.clip(qcol - NA_KW // 2, 0, GRID_W - NA_KW)
    col_mask = (kcol[:, None, :] >= win[:, :, None]) & (kcol[:, None, :] < win[:, :, None] + NA_KW)
    col_off = np.clip(kcol[:, None, :] - qcol[:, :, None] + (NA_KW - 1), 0, 2 * NA_KW - 2)
    return kh, row_start, row_off, kcol, col_mask, col_off


def na_mixer(h, w_in, rpb, w_out):
    b, s, _ = h.shape
    rows = s // GRID_W
    kh, row_start, row_off, kcol, col_mask, col_off = na_tables(rows)
    ncb = GRID_W // NA_QCB
    q, k, v, z = jnp.split(h @ w_in, 4, axis=-1)
    grid = lambda t: t.reshape(b, rows, GRID_W, NA_HEADS, NA_HDIM)
    q = grid(q) * (NA_HDIM ** -0.5)
    k, v = grid(k), grid(v)
    qb = jnp.moveaxis(q.reshape(b, rows, ncb, NA_QCB, NA_HEADS, NA_HDIM), 1, 0)
    mask = jnp.asarray(col_mask)[:, :, None, :]
    col_off_j = jnp.asarray(col_off)

    def one_row(args):
        q_r, rs, ro = args
        k_rows = lax.dynamic_slice_in_dim(k, rs, kh, axis=1)
        v_rows = lax.dynamic_slice_in_dim(v, rs, kh, axis=1)
        k_blk = k_rows[:, :, kcol]
        v_blk = v_rows[:, :, kcol]
        sc = jnp.einsum('bjqhd,brjkhd->bhjqrk', q_r, k_blk).astype(jnp.float32)
        bias = rpb[:, ro, :][:, :, col_off_j]
        sc = sc + jnp.transpose(bias, (0, 2, 3, 1, 4)).astype(jnp.float32)
        sc = jnp.where(mask, sc, -jnp.inf)
        shp = sc.shape
        p = jax.nn.softmax(sc.reshape(shp[:-2] + (kh * NA_KCB,)), axis=-1).reshape(shp)
        return jnp.einsum('bhjqrk,brjkhd->bjqhd', p.astype(v.dtype), v_blk)

    o = lax.map(one_row, (qb, jnp.asarray(row_start, jnp.int32), jnp.asarray(row_off, jnp.int32)))
    o = jnp.moveaxis(o, 0, 1).reshape(b, s, BRANCH)
    return (o * jax.nn.silu(z)) @ w_out


def apply_rope(x, s):
    half = MLA_ROPE // 2
    inv = ROPE_THETA ** (-jnp.arange(half, dtype=jnp.float32) / half)
    ang = jnp.arange(s, dtype=jnp.float32)[:, None] * inv[None, :]
    ang = ang.reshape((1, s) + (1,) * (x.ndim - 3) + (half,))
    cos, sin = jnp.cos(ang), jnp.sin(ang)
    xf = x.astype(jnp.float32)
    x1, x2 = xf[..., :half], xf[..., half:]
    return jnp.concatenate([x1 * cos - x2 * sin, x1 * sin + x2 * cos], axis=-1).astype(x.dtype)


def mla_mixer(h, w_in, g_q, w_uq, g_kv, w_ukv, w_out):
    b, s, _ = h.shape
    c_q, c_kv, k_pe, z = jnp.split(h @ w_in, [MLA_Q_LORA, MLA_Q_LORA + MLA_KV_LORA,
                                              MLA_Q_LORA + MLA_KV_LORA + MLA_ROPE], axis=-1)
    scale = (MLA_NOPE + MLA_ROPE) ** -0.5
    q = (rmsnorm(c_q, g_q) @ w_uq).reshape(b, s, MLA_HEADS, MLA_NOPE + MLA_ROPE) * scale
    q_nope, q_pe = q[..., :MLA_NOPE], apply_rope(q[..., MLA_NOPE:], s)
    k_pe = apply_rope(k_pe, s)
    kv = (rmsnorm(c_kv, g_kv) @ w_ukv).reshape(b, s, MLA_HEADS, MLA_NOPE + MLA_V)
    k_nope, v = kv[..., :MLA_NOPE], kv[..., MLA_NOPE:]
    nblk = s // MLA_QBLOCK
    qn = jnp.moveaxis(q_nope.reshape(b, nblk, MLA_QBLOCK, MLA_HEADS, MLA_NOPE), 1, 0)
    qp = jnp.moveaxis(q_pe.reshape(b, nblk, MLA_QBLOCK, MLA_HEADS, MLA_ROPE), 1, 0)

    def block(args):
        qn_i, qp_i = args
        sc = (jnp.einsum('bqhd,bkhd->bhqk', qn_i, k_nope).astype(jnp.float32)
              + jnp.einsum('bqhr,bkr->bhqk', qp_i, k_pe).astype(jnp.float32))
        p = jax.nn.softmax(sc, axis=-1).astype(v.dtype)
        return jnp.einsum('bhqk,bkhd->bqhd', p, v)

    o = lax.map(block, (qn, qp))
    o = jnp.moveaxis(o, 0, 1).reshape(b, s, BRANCH)
    return (o * jax.nn.silu(z)) @ w_out


def gla_chunk_scan(q, k, v, logf):
    b, s, nh, dk = q.shape
    dv = v.shape[-1]
    n = s // HG_CHUNK
    to_chunks = lambda t: jnp.moveaxis(t.reshape(b, n, HG_CHUNK, nh, t.shape[-1]), 1, 0)
    causal = jnp.tril(jnp.ones((HG_CHUNK, HG_CHUNK), bool))[None, :, :, None, None]

    def step(S, inp):
        qc, kc, vc, gc = inp
        B = jnp.cumsum(gc, axis=1)
        decay = jnp.exp(jnp.where(causal, B[:, :, None] - B[:, None, :], -jnp.inf))
        A = jnp.einsum('bthc,btshc,bshc->bhts', qc, decay, kc)
        o = jnp.einsum('bhts,bshv->bthv', A, vc) + jnp.einsum('bthc,bhcv->bthv', qc * jnp.exp(B), S)
        BL = B[:, -1]
        S_new = jnp.exp(BL)[..., None] * S + jnp.einsum('bshc,bshv->bhcv', kc * jnp.exp(BL[:, None] - B), vc)
        return S_new, o

    S0 = jnp.zeros((b, nh, dk, dv), jnp.float32)
    _, o = lax.scan(step, S0, (to_chunks(q), to_chunks(k), to_chunks(v), to_chunks(logf)))
    return jnp.moveaxis(o, 0, 1).reshape(b, s, nh, dv)


def hgrn2_mixer(h, w_in, lower, g_out, w_out):
    b, s, _ = h.shape
    q, f_fw, f_bw, i, z = jnp.split(h @ w_in, 5, axis=-1)
    heads = lambda t: t.astype(jnp.float32).reshape(b, s, HG_HEADS, -1)
    q = jax.nn.silu(heads(q))
    i = heads(i)

    def direction(f_raw, lb):
        f = heads(lb + (1.0 - lb) * jax.nn.sigmoid(f_raw.astype(jnp.float32)))
        return jnp.log(f), 1.0 - f

    lf_f, k_f = direction(f_fw, lower[0])
    lf_b, k_b = direction(f_bw, lower[1])
    o_f = gla_chunk_scan(q, k_f, i, lf_f)
    flip = lambda t: jnp.flip(t, axis=1)
    o_b = flip(gla_chunk_scan(flip(q), flip(k_b), flip(i), flip(lf_b)))
    o = o_f + o_b
    o = o * lax.rsqrt(jnp.mean(o * o, axis=-1, keepdims=True) + EPS)
    o = (o.reshape(b, s, BRANCH) * g_out.astype(jnp.float32)).astype(h.dtype)
    return (o * jax.nn.silu(z)) @ w_out


def trunk(x, p, norm_g, fn_w_in, fn_w_mix, fn_w_out, na_w_in, na_rpb, na_w_out,
          mla_w_in, mla_g_q, mla_w_uq, mla_g_kv, mla_w_ukv, mla_w_out,
          hg_w_in, hg_lb_raw, hg_g_out, hg_w_out, ple_w, ple_gate_w, final_g):
    sm = jax.nn.softmax(hg_lb_raw.astype(jnp.float32), axis=0)
    lower = jnp.cumsum(sm, axis=0) - sm[0]
    for li in range(DEPTH):
        m, j = li % N_MIXERS, li // N_MIXERS
        h = rmsnorm(x, norm_g[li])
        if m == 0:
            y = fourier_mixer(h, fn_w_in[j], fn_w_mix[j], fn_w_out[j])
        elif m == 1:
            y = na_mixer(h, na_w_in[j], na_rpb[j], na_w_out[j])
        elif m == 2:
            y = mla_mixer(h, mla_w_in[j], mla_g_q[j], mla_w_uq[j], mla_g_kv[j], mla_w_ukv[j], mla_w_out[j])
        else:
            y = hgrn2_mixer(h, hg_w_in[j], lower[li], hg_g_out[j], hg_w_out[j])
        x = x + y
        x = x + jax.nn.sigmoid(x @ ple_gate_w[li]) * (p[li] @ ple_w[li])
    return rmsnorm(x, final_g)


def setup_inputs(seed: int = 0) -> dict:
    key = jax.random.key(seed)
    ks = iter(jax.random.split(key, 32))
    nrm = lambda shape, scale: jax.random.normal(next(ks), shape, jnp.float32) * scale
    gain = lambda shape: 1.0 + nrm(shape, 0.02)
    nA, nB, nC, nD = (len(range(m, DEPTH, N_MIXERS)) for m in range(N_MIXERS))
    D = D_MODEL
    return {
        "x_prompt": nrm((BATCH, SEQ, D), 1.0),
        "x_sample": nrm((DEC_BATCH, DEC_SEQ, D), 1.0),
        "p_prompt": nrm((DEPTH, BATCH, SEQ, PLE_DIM), 1.0),
        "p_sample": nrm((DEPTH, DEC_BATCH, DEC_SEQ, PLE_DIM), 1.0),
        "norm_g": gain((DEPTH, D)),
        "fn_w_in": nrm((nA, D, 2 * BRANCH), D ** -0.5),
        "fn_w_mix": nrm((nA, FN_GROUPS, FN_GDIM, FN_GDIM), FN_GDIM ** -0.5),
        "fn_w_out": nrm((nA, BRANCH, D), BRANCH ** -0.5),
        "na_w_in": nrm((nB, D, 4 * BRANCH), D ** -0.5),
        "na_rpb": nrm((nB, NA_HEADS, 2 * NA_KH_MAX - 1, 2 * NA_KW - 1), 0.1),
        "na_w_out": nrm((nB, BRANCH, D), BRANCH ** -0.5),
        "mla_w_in": nrm((nC, D, MLA_Q_LORA + MLA_KV_LORA + MLA_ROPE + BRANCH), D ** -0.5),
        "mla_g_q": gain((nC, MLA_Q_LORA)),
        "mla_w_uq": nrm((nC, MLA_Q_LORA, MLA_HEADS * (MLA_NOPE + MLA_ROPE)), MLA_Q_LORA ** -0.5),
        "mla_g_kv": gain((nC, MLA_KV_LORA)),
        "mla_w_ukv": nrm((nC, MLA_KV_LORA, MLA_HEADS * (MLA_NOPE + MLA_V)), MLA_KV_LORA ** -0.5),
        "mla_w_out": nrm((nC, BRANCH, D), BRANCH ** -0.5),
        "hg_w_in": nrm((nD, D, 5 * BRANCH), D ** -0.5),
        "hg_lb_raw": nrm((DEPTH, 2, BRANCH), 0.1),
        "hg_g_out": gain((nD, BRANCH)),
        "hg_w_out": nrm((nD, BRANCH, D), BRANCH ** -0.5),
        "ple_w": nrm((DEPTH, PLE_DIM, D), PLE_DIM ** -0.5),
        "ple_gate_w": nrm((DEPTH, D, D), D ** -0.5),
        "final_g": gain((D,)),
    }


def reference(x_prompt, x_sample, p_prompt, p_sample, norm_g, fn_w_in, fn_w_mix, fn_w_out,
              na_w_in, na_rpb, na_w_out, mla_w_in, mla_g_q, mla_w_uq, mla_g_kv, mla_w_ukv, mla_w_out,
              hg_w_in, hg_lb_raw, hg_g_out, hg_w_out, ple_w, ple_gate_w, final_g):
    y_prompt = trunk(x_prompt, p_prompt, norm_g, fn_w_in, fn_w_mix, fn_w_out, na_w_in, na_rpb, na_w_out,
                     mla_w_in, mla_g_q, mla_w_uq, mla_g_kv, mla_w_ukv, mla_w_out,
                     hg_w_in, hg_lb_raw, hg_g_out, hg_w_out, ple_w, ple_gate_w, final_g)
    y_sample = trunk(x_sample, p_sample, norm_g, fn_w_in, fn_w_mix, fn_w_out, na_w_in, na_rpb, na_w_out,
                     mla_w_in, mla_g_q, mla_w_uq, mla_g_kv, mla_w_ukv, mla_w_out,
                     hg_w_in, hg_lb_raw, hg_g_out, hg_w_out, ple_w, ple_gate_w, final_g)
    return (y_prompt, y_sample)
```

```cpp
#include <hip/hip_runtime.h>
#include <hip/hip_fp16.h>
#include <hip/hip_cooperative_groups.h>
#include <cstdio>
#include <cstring>
namespace cg = cooperative_groups;

#define DI __device__ __forceinline__
typedef unsigned short u16;
typedef __attribute__((ext_vector_type(8))) short bf16x8;
typedef __attribute__((ext_vector_type(4))) short s16x4;
typedef __attribute__((ext_vector_type(4))) float f32x4;
typedef __attribute__((ext_vector_type(4))) unsigned u32x4;
typedef __attribute__((ext_vector_type(2))) unsigned u32x2;

constexpr int T_TOK = 81920;
constexpr int TP = 16384;
constexpr long SL = (long)T_TOK * 1024 * 2;
constexpr int NTHR = 512;
constexpr int SMEM_BYTES = 147456;

#define MFMA16(a, b, c) __builtin_amdgcn_mfma_f32_16x16x32_bf16((a), (b), (c), 0, 0, 0)

DI int tid_opaque() { int t = threadIdx.x; asm volatile("" : "+v"(t)); return t; }
typedef __attribute__((ext_vector_type(2))) __bf16 bf16x2_t;
typedef __attribute__((ext_vector_type(2))) float f32x2_t;
DI unsigned pack2(float a, float b) { f32x2_t v = {a, b}; return __builtin_bit_cast(unsigned, __builtin_convertvector(v, bf16x2_t)); }
DI u16 f2bf(float x) { return (u16)(pack2(x, 0.f) & 0xffffu); }
DI float bf2f(u16 v) { return __uint_as_float(((unsigned)v) << 16); }
DI float bflo(unsigned u) { return __uint_as_float(u << 16); }
DI float bfhi(unsigned u) { return __uint_as_float(u & 0xffff0000u); }
DI float sigm(float v) { return __builtin_amdgcn_rcpf(1.f + __expf(-v)); }
DI float silu(float v) { return v * __builtin_amdgcn_rcpf(1.f + __expf(-v)); }
DI u32x2 pack4(float a, float b, float c, float d) { u32x2 r; r.x = pack2(a, b); r.y = pack2(c, d); return r; }
DI bf16x8 pack8(f32x4 a, f32x4 b) {
  u32x4 r; r.x = pack2(a[0], a[1]); r.y = pack2(a[2], a[3]); r.z = pack2(b[0], b[1]); r.w = pack2(b[2], b[3]);
  return __builtin_bit_cast(bf16x8, r);
}
DI bf16x8 cat8(s16x4 lo, s16x4 hi) { return __builtin_shufflevector(lo, hi, 0, 1, 2, 3, 4, 5, 6, 7); }

struct TJob { const float* src; const float* g; u16* dst; int ld; int col0; int K; int N; float scale; int tile0; };

struct Params {
  const float *x_prompt, *x_sample, *p_prompt, *p_sample, *norm_g, *fn_w_in, *fn_w_mix, *na_rpb, *hg_lb_raw, *hg_g_out, *final_g;
  float* out;
  u16 *buf0, *buf1;
  unsigned char* proj;
  u16 *Wfn, *Wfn_out, *Wna, *Wna_out, *Wmla_in, *Wmla_z, *Wuq, *Wukv, *Wmla_out, *Whg, *Whg_z, *Whg_out, *Wp, *Wg;
  float *CW, *rope, *ssq, *ssq_q, *ssq_kv, *lb;
  unsigned* bar;
  int njobs, ntjt;
  TJob jobs[40];
};

#define LDS_PTR(p) ((__attribute__((address_space(3))) unsigned*)(p))
template <int PIPE>
DI void gemm_loop_g(const u16* __restrict__ Xp, long ldx_l, long ldx_i, long kxs,
                    const u16* __restrict__ Yp, long ldy_l, long ldy_i, long kys, int K,
                    f32x4 (&acc)[4][8], unsigned char* smem) {
  const int t = tid_opaque(), l = t & 63, w = __builtin_amdgcn_readfirstlane(t >> 6), wx = w >> 1, wy = w & 1;
  const int lrow = t >> 3, gch = (t & 7) ^ ((t >> 4) & 7);
  const u16* xs = Xp + (long)lrow * ldx_l + gch * 8;
  const u16* ys = Yp + (long)lrow * ldy_l + gch * 8;
  const int fsw = (l >> 1) & 7, lg = l >> 4;
  const unsigned fr0 = (l & 15) * 128 + ((lg ^ fsw) << 4);
  const unsigned fr1 = (l & 15) * 128 + (((lg + 4) ^ fsw) << 4);
  const unsigned ub = wx * 8192, vb = 32768 + wy * 16384;
  const int nk = K >> 6;
  const int rot = (int)((blockIdx.x >> 3) + (blockIdx.x & 7) * 5) % nk;
  auto issue = [&](int kt0, int stage) {
    int kt = kt0 + rot; if (kt >= nk) kt -= nk;
    unsigned char* sb = smem + stage * 65536 + t * 16;
#pragma unroll
    for (int i = 0; i < 4; ++i)
      __builtin_amdgcn_global_load_lds((const unsigned*)(xs + i * ldx_i + kt * kxs), LDS_PTR(sb + i * 8192), 16, 0, 0);
#pragma unroll
    for (int i = 0; i < 4; ++i)
      __builtin_amdgcn_global_load_lds((const unsigned*)(ys + i * ldy_i + kt * kys), LDS_PTR(sb + 32768 + i * 8192), 16, 0, 0);
  };
  __syncthreads();
  issue(0, 0);
  asm volatile("s_waitcnt vmcnt(0)" ::: "memory");
  __syncthreads();
#pragma unroll 1
  for (int kt = 0; kt < nk; ++kt) {
    const unsigned char* cur = smem + (kt & 1) * 65536;
    if (kt + 1 < nk) issue(kt + 1, (kt + 1) & 1);
    if (PIPE) {
      bf16x8 u0[4], u1[4], vf[8];
#pragma unroll
      for (int i = 0; i < 4; ++i) u0[i] = *(const bf16x8*)(cur + ub + i * 2048 + fr0);
#pragma unroll
      for (int j = 0; j < 8; ++j) vf[j] = *(const bf16x8*)(cur + vb + j * 2048 + fr0);
#pragma unroll
      for (int j = 0; j < 8; ++j) {
#pragma unroll
        for (int i = 0; i < 4; ++i) acc[i][j] = MFMA16(u0[i], vf[j], acc[i][j]);
        vf[j] = *(const bf16x8*)(cur + vb + j * 2048 + fr1);
        if (j < 4) u1[j] = *(const bf16x8*)(cur + ub + j * 2048 + fr1);
        if (j & 1) __builtin_amdgcn_sched_barrier(0);
      }
#pragma unroll
      for (int j = 0; j < 8; ++j)
#pragma unroll
        for (int i = 0; i < 4; ++i) acc[i][j] = MFMA16(u1[i], vf[j], acc[i][j]);
    }
    else {
#pragma unroll
      for (int ks = 0; ks < 2; ++ks) {
        const unsigned fr = ks ? fr1 : fr0;
        bf16x8 uf[4], vf[8];
#pragma unroll
        for (int i = 0; i < 4; ++i) uf[i] = *(const bf16x8*)(cur + ub + i * 2048 + fr);
#pragma unroll
        for (int j = 0; j < 8; ++j) vf[j] = *(const bf16x8*)(cur + vb + j * 2048 + fr);
#pragma unroll
        for (int i = 0; i < 4; ++i)
#pragma unroll
          for (int j = 0; j < 8; ++j) acc[i][j] = MFMA16(uf[i], vf[j], acc[i][j]);
      }
    }
    asm volatile("s_waitcnt vmcnt(0)" ::: "memory");
    __syncthreads();
  }
}

DI void gemm_loop(const u16* __restrict__ Xp, long ldx, const u16* __restrict__ Yp, long ldy, int K,
                  f32x4 (&acc)[4][8], unsigned char* smem) {
  gemm_loop_g<1>(Xp, ldx, 64 * ldx, 64, Yp, ldy, 64 * ldy, 64, K, acc, smem);
}

DI void zero_acc(f32x4 (&acc)[4][8]) {
#pragma unroll
  for (int i = 0; i < 4; ++i)
#pragma unroll
    for (int j = 0; j < 8; ++j) acc[i][j] = f32x4{0.f, 0.f, 0.f, 0.f};
}

#define EPI_STD_BEGIN                                                        \
  _Pragma("unroll") for (int j = 0; j < 8; ++j) _Pragma("unroll") for (int i = 0; i < 4; ++i) { \
    const int n4 = n0 + wx * 64 + i * 16 + lg * 4;                           \
    const int m = m0 + wy * 128 + j * 16 + lq;                               \
    const f32x4 v = acc[i][j];
#define EPI_TR_BEGIN                                                         \
  _Pragma("unroll") for (int j = 0; j < 8; ++j) _Pragma("unroll") for (int i = 0; i < 4; ++i) { \
    const int m4 = m0 + wx * 64 + i * 16 + lg * 4;                           \
    const int n = n0 + wy * 128 + j * 16 + lq;                               \
    const f32x4 v = acc[i][j];
#define EPI_END if (i == 3 && (j & 3) == 3) __builtin_amdgcn_sched_barrier(0); }

DI float rstd_of(const float* ssq, int m, float invn) { return rsqrtf(ssq[m] * invn + 1e-6f); }

DI void prep_rows(const Params& p) {
  const int tt_ = tid_opaque();
  const int l = tt_ & 63, gw = blockIdx.x * 8 + (tt_ >> 6), nw = gridDim.x * 8;
  for (int row = gw; row < T_TOK; row += nw) {
    const float* src = row < TP ? p.x_prompt + (long)row * 1024 : p.x_sample + (long)(row - TP) * 1024;
    float4 v[4];
    float s = 0.f;
#pragma unroll
    for (int i = 0; i < 4; ++i) {
      v[i] = ((const float4*)src)[l + 64 * i];
      s += v[i].x * v[i].x + v[i].y * v[i].y + v[i].z * v[i].z + v[i].w * v[i].w;
    }
#pragma unroll
    for (int o = 1; o < 64; o <<= 1) s += __shfl_xor(s, o);
#pragma unroll
    for (int i = 0; i < 4; ++i) {
      *(u32x2*)(p.buf0 + (long)row * 1024 + (l + 64 * i) * 4) = pack4(v[i].x, v[i].y, v[i].z, v[i].w);
    }
    if (l == 0) p.ssq[row] = s;
  }
}

DI void prep_transposes(const Params& p, unsigned char* smem) {
  float* ts = (float*)smem;
  const int t = tid_opaque();
  for (int id = blockIdx.x; id < p.ntjt; id += gridDim.x) {
    int ji = 0;
    while (ji + 1 < p.njobs && id >= p.jobs[ji + 1].tile0) ++ji;
    const TJob jb = p.jobs[ji];
    const int loc = id - jb.tile0, tn_n = jb.N >> 6;
    const int tk = loc / tn_n, tn = loc - tk * tn_n;
    {
      const int r = t >> 4, c4 = (t & 15) * 4;
#pragma unroll
      for (int hh = 0; hh < 2; ++hh) {
        const int k = tk * 64 + r + 32 * hh;
        float4 v = *(const float4*)(jb.src + (long)k * jb.ld + jb.col0 + tn * 64 + c4);
        const float gk = jb.g ? jb.g[k] * jb.scale : jb.scale;
        float* d = ts + (r + 32 * hh) * 65 + c4;
        d[0] = v.x * gk; d[1] = v.y * gk; d[2] = v.z * gk; d[3] = v.w * gk;
      }
    }
    __syncthreads();
    {
      const int n = t >> 3, k8 = (t & 7) * 8;
      u32x4 o;
      o.x = pack2(ts[(k8 + 0) * 65 + n], ts[(k8 + 1) * 65 + n]);
      o.y = pack2(ts[(k8 + 2) * 65 + n], ts[(k8 + 3) * 65 + n]);
      o.z = pack2(ts[(k8 + 4) * 65 + n], ts[(k8 + 5) * 65 + n]);
      o.w = pack2(ts[(k8 + 6) * 65 + n], ts[(k8 + 7) * 65 + n]);
      *(u32x4*)(jb.dst + (long)(tn * 64 + n) * jb.K + tk * 64 + k8) = o;
    }
    __syncthreads();
  }
}

DI void prep_misc(const Params& p) {
  const long gt = (long)blockIdx.x * NTHR + tid_opaque(), gn = (long)gridDim.x * NTHR;
  {
    u16* F2 = (u16*)(p.proj + 3 * SL); u16* G = F2 + 256 * 128; float* tw = (float*)(G + 256 * 128);
    for (long id = gt; id < 256L * 128; id += gn) {
      const int row = (int)(id >> 7), kk = (int)(id & 127), b = kk & 63, hi = kk >> 6;
      float f2 = 0.f, gg = 0.f;
      if (row < 128) {
        const int v = row & 63, im = row >> 6;
        float sn, cs;
        sincospif((float)((v * b) & 63) * (1.f / 32.f), &sn, &cs);
        f2 = (im ? (hi ? cs : sn) : (hi ? -sn : cs)) * 0.125f;
        if (row < 64) gg = (hi ? -sn : cs) * 0.125f;
      }
      F2[id] = f2bf(f2); G[id] = f2bf(gg);
    }
    for (long id = gt; id < 4096; id += gn) {
      const int v = (int)(id >> 6), a = (int)(id & 63);
      float sn, cs;
      sincospif((float)(v * a) * (1.f / 2048.f), &sn, &cs);
      tw[id * 2] = cs; tw[id * 2 + 1] = sn;
    }
  }
  for (long id = gt; id < 4096L * 32; id += gn) {
    const int pos = (int)(id >> 5), i = (int)(id & 31);
    const double inv = pow(10000.0, -(double)i / 32.0);
    double sn, cs;
    sincos((double)pos * inv, &sn, &cs);
    p.rope[id * 2] = (float)cs; p.rope[id * 2 + 1] = (float)sn;
  }
  for (long id = gt; id < 8L * 128 * 256; id += gn) {
    const int col = (int)(id & 255), c = (int)((id >> 8) & 127), g = (int)(id >> 15);
    const int d = col & 127, is_sin = col >> 7;
    float a = 0.f;
    for (int lq = 0; lq < 128; ++lq) {
      float sn, cs;
      sincospif((float)((lq * c) & 127) * (1.f / 64.f), &sn, &cs);
      a += (is_sin ? sn : cs) * p.fn_w_mix[((long)g * 128 + lq) * 128 + d];
    }
    p.CW[id] = a * 0.08838834764831845f;
  }
  for (long id = gt; id < 2048; id += gn) {
    float r0 = p.hg_lb_raw[id], r1 = p.hg_lb_raw[2048 + id], r2 = p.hg_lb_raw[4096 + id], r3 = p.hg_lb_raw[6144 + id];
    float mx = fmaxf(fmaxf(r0, r1), fmaxf(r2, r3));
    float e0 = __expf(r0 - mx), e1 = __expf(r1 - mx), e2 = __expf(r2 - mx), e3 = __expf(r3 - mx);
    p.lb[id] = (e1 + e2 + e3) / (e0 + e1 + e2 + e3);
  }
  for (long id = gt; id < 4L * T_TOK; id += gn) p.ssq[T_TOK + id] = 0.f;
  for (long id = gt; id < T_TOK; id += gn) { p.ssq_q[id] = 0.f; p.ssq_kv[id] = 0.f; }
  for (long id = gt; id < 64L * 1024; id += gn) p.Wmla_in[704L * 1024 + id] = 0;
}

DI void prep_wprime(const Params& p) {
  const long gt = (long)blockIdx.x * NTHR + tid_opaque(), gn = (long)gridDim.x * NTHR;
  for (long id = gt; id < 2048L * 1024; id += gn) {
    const int k = (int)(id & 1023), np = (int)(id >> 10), g = np >> 8, col = np & 255;
    const float4* wi = (const float4*)(p.fn_w_in + (long)k * 2048 + g * 128);
    const float* cw = p.CW + (long)g * 128 * 256 + col;
    float a = 0.f;
    for (int c4 = 0; c4 < 32; ++c4) {
      float4 v = wi[c4];
      a += v.x * cw[(c4 * 4 + 0) * 256] + v.y * cw[(c4 * 4 + 1) * 256] + v.z * cw[(c4 * 4 + 2) * 256] + v.w * cw[(c4 * 4 + 3) * 256];
    }
    p.Wfn[id] = f2bf(a * p.norm_g[k]);
  }
}

enum { M_FN_IN, M_SEQ, M_OUT, M_PLE, M_NA_IN, M_MLA_IN, M_MLA_UQ, M_MLA_UKV, M_ZPASS, M_HG_IN, M_FFT1 = 14, M_FFT3 = 15 };

struct GP {
  const u16* A; long lda; const u16* W; int K; int ntn; int ntiles;
  void *d0, *d1, *d2, *d3;
  const float* ssq_in; float* ssq_out; float* ssq_out2;
  const u16* W2; int li;
};

#ifndef PH_MASK
#define PH_MASK 0xffffffffu
#endif
template <int MODE>
DI void gemm_phase(const Params& p, const GP& g, unsigned char* smem) {
  if (!((PH_MASK >> MODE) & 1u)) return;
  const int t = tid_opaque(), l = t & 63, w = __builtin_amdgcn_readfirstlane(t >> 6), wx = w >> 1, wy = w & 1, lq = l & 15, lg = l >> 4;
  const int xcd = blockIdx.x & 7, slot = blockIdx.x >> 3, nslot = gridDim.x >> 3;
  const int nent = (g.ntiles >> 3);
  for (int e = slot; e < nent; e += nslot) {
    int mt, nt;
    const u16* Ab = g.A; const u16* Wb = g.W;
    int bsel = 0;
    {
      const int ml = e / g.ntn;
      nt = e - ml * g.ntn;
      mt = xcd + 8 * ml;
    }
    if (MODE == M_SEQ) { bsel = mt >> 4; mt &= 15; Wb = g.W + (long)bsel * 1024 * 8192; }
    const int m0 = mt * 256, n0 = nt * 256;
    f32x4 acc[4][8];
    zero_acc(acc);
    int transposed = 0;
    if (MODE == M_FN_IN) transposed = nt < 8;
    if (MODE == M_NA_IN) transposed = (nt >= 8 && nt < 12);
    if (MODE == M_MLA_UKV) transposed = nt >= 4;
    if (MODE == M_HG_IN) transposed = nt >= 12;
    if (MODE == M_PLE) {
      const u16* pb = (const u16*)g.d1;
      gemm_loop(g.W2 + (long)n0 * 256, 256, pb + (long)m0 * 256, 256, 256, acc, smem);
      u16* xb = (u16*)g.d0;
      EPI_STD_BEGIN
        *(u32x2*)(xb + (long)m * 1024 + n4) = pack4(v[0], v[1], v[2], v[3]);
      EPI_END
      zero_acc(acc);
    }
    if (MODE == M_FFT1) {
      const int bt = mt >> 8, cg = mt & 255;
      gemm_loop_g<0>(Ab + ((long)(bt * 1024 + cg * 4)) * 8192, 64, 8192, 4096, Wb, 128, 64 * 128, 64, 128, acc, smem);
    } else if (MODE == M_FFT3) {
      const int bt = mt >> 8, v = (mt >> 2) & 63, cq = mt & 3;
      gemm_loop(Ab + (((long)(bt * 64 + v)) * 1024 + cq * 256) * 128, 128, Wb, 128, 128, acc, smem);
    } else if (MODE == M_FN_IN && transposed) {
      const u16* Ap = Ab + ((long)(mt >> 4) * 4096 + (mt & 15) * 4) * g.lda;
      gemm_loop_g<1>(Ap, 64 * g.lda, g.lda, 64, Wb + (long)n0 * g.K, g.K, 64L * g.K, 64, g.K, acc, smem);
    } else {
      const u16* Ap = Ab + (long)m0 * g.lda; const u16* Wp = Wb + (long)n0 * g.K;
      if (transposed) gemm_loop(Ap, g.lda, Wp, g.K, g.K, acc, smem);
      else gemm_loop(Wp, g.K, Ap, g.lda, g.K, acc, smem);
    }

    if (MODE == M_FN_IN) {
      if (transposed) {
        u16* Pt = (u16*)g.d0;
        const int bt = mt >> 4, a = (mt & 15) * 4 + wx;
        EPI_TR_BEGIN
          const int grp = n >> 8, half = (n >> 7) & 1, c = grp * 128 + (n & 127);
          const int b0 = i * 16 + lg * 4;
          const int tok = bt * 4096 + a + 64 * b0;
          (void)m4;
          *(u32x2*)(Pt + (((long)bt * 1024 + c) * 2 + half) * 4096 + a * 64 + b0) =
              pack4(v[0] * rstd_of(g.ssq_in, tok, 1.f / 1024), v[1] * rstd_of(g.ssq_in, tok + 64, 1.f / 1024),
                    v[2] * rstd_of(g.ssq_in, tok + 128, 1.f / 1024), v[3] * rstd_of(g.ssq_in, tok + 192, 1.f / 1024));
        EPI_END
      } else {
        u16* z = (u16*)g.d1;
        EPI_STD_BEGIN
          const float rs = rstd_of(g.ssq_in, m, 1.f / 1024);
          *(u32x2*)(z + (long)m * 1024 + (n4 - 2048)) = pack4(v[0] * rs, v[1] * rs, v[2] * rs, v[3] * rs);
        EPI_END
      }
    } else if (MODE == M_FFT1) {
      if (wy == 0) {
        u16* Zs = (u16*)g.d0; const float* tw = (const float*)g.d1;
        const int bt = mt >> 8, c = (mt & 255) * 4 + wx;
#pragma unroll
        for (int jj = 0; jj < 4; ++jj)
#pragma unroll
          for (int i = 0; i < 4; ++i) {
            const int a4 = i * 16 + lg * 4, v = jj * 16 + lq;
            const float4 t0 = *(const float4*)(tw + (v * 64 + a4) * 2), t1 = *(const float4*)(tw + (v * 64 + a4) * 2 + 4);
            const f32x4 zr = acc[i][jj], zi = acc[i][jj + 4];
            const long base = ((((long)(bt * 64 + v)) * 1024 + c) * 2) * 64 + a4;
            *(u32x2*)(Zs + base) = pack4(zr[0] * t0.x - zi[0] * t0.y, zr[1] * t0.z - zi[1] * t0.w,
                                         zr[2] * t1.x - zi[2] * t1.y, zr[3] * t1.z - zi[3] * t1.w);
            *(u32x2*)(Zs + base + 64) = pack4(zr[0] * t0.y + zi[0] * t0.x, zr[1] * t0.w + zi[1] * t0.z,
                                              zr[2] * t1.y + zi[2] * t1.x, zr[3] * t1.w + zi[3] * t1.z);
            __builtin_amdgcn_sched_barrier(0);
          }
      }
    } else if (MODE == M_FFT3) {
      if (wy == 0) {
        u16* og = (u16*)g.d0; const u16* z = (const u16*)g.d1;
        const int bt = mt >> 8, v = (mt >> 2) & 63, cq = mt & 3;
#pragma unroll
        for (int j = 0; j < 4; ++j)
#pragma unroll
          for (int i = 0; i < 4; ++i) {
            const int c4 = cq * 256 + wx * 64 + i * 16 + lg * 4, u = j * 16 + lq;
            const long o = ((long)bt * 4096 + 64 * u + v) * 1024 + c4;
            const f32x4 val = acc[i][j];
            const u32x2 zz = *(const u32x2*)(z + o);
            *(u32x2*)(og + o) = pack4(val[0] * silu(bflo(zz.x)), val[1] * silu(bfhi(zz.x)), val[2] * silu(bflo(zz.y)), val[3] * silu(bfhi(zz.y)));
            if (i == 3) __builtin_amdgcn_sched_barrier(0);
          }
      }
    } else if (MODE == M_SEQ) {
      u16* og = (u16*)g.d0; const u16* z = (const u16*)g.d1;
      EPI_STD_BEGIN
        const long o = ((long)bsel * 4096 + m) * 1024 + n4;
        const u32x2 zz = *(const u32x2*)(z + o);
        *(u32x2*)(og + o) = pack4(v[0] * silu(bflo(zz.x)), v[1] * silu(bfhi(zz.x)), v[2] * silu(bflo(zz.y)), v[3] * silu(bfhi(zz.y)));
      EPI_END
    } else if (MODE == M_OUT) {
      u16* xb = (u16*)g.d0;
      const float* xin = g.li ? p.out : (m0 < TP ? p.x_prompt : p.x_sample - (long)TP * 1024);
      EPI_STD_BEGIN
        float4* xp = (float4*)(p.out + (long)m * 1024 + n4);
        float4 xv = *(const float4*)(xin + (long)m * 1024 + n4);
        xv.x += v[0]; xv.y += v[1]; xv.z += v[2]; xv.w += v[3];
        *xp = xv;
        *(u32x2*)(xb + (long)m * 1024 + n4) = pack4(xv.x, xv.y, xv.z, xv.w);
      EPI_END
    } else if (MODE == M_PLE) {
      u16* xb = (u16*)g.d0;
      asm volatile("" : "+s"(xb));
#pragma unroll
      for (int j = 0; j < 8; ++j) {
        const int m = m0 + wy * 128 + j * 16 + lq;
        float sq = 0.f;
#pragma unroll
        for (int i = 0; i < 4; ++i) {
          const int n4 = n0 + wx * 64 + i * 16 + lg * 4;
          const f32x4 v = acc[i][j];
          const u32x2 pv = *(const u32x2*)(xb + (long)m * 1024 + n4);
          float4* xp = (float4*)(p.out + (long)m * 1024 + n4);
          float4 xv = *xp;
          xv.x += sigm(v[0]) * bflo(pv.x); xv.y += sigm(v[1]) * bfhi(pv.x); xv.z += sigm(v[2]) * bflo(pv.y); xv.w += sigm(v[3]) * bfhi(pv.y);
          *xp = xv;
          if (g.li != 3) *(u32x2*)(xb + (long)m * 1024 + n4) = pack4(xv.x, xv.y, xv.z, xv.w);
          sq += xv.x * xv.x + xv.y * xv.y + xv.z * xv.z + xv.w * xv.w;
        }
        sq += __shfl_xor(sq, 16);
        sq += __shfl_xor(sq, 32);
        if (lg == 0) atomicAdd(g.ssq_out + m, sq);
        __builtin_amdgcn_sched_barrier(0);
      }
    } else if (MODE == M_NA_IN) {
      if (transposed) {
        u16* Vt = (u16*)g.d2;
        EPI_TR_BEGIN
          const int b = m4 >> 12, s = m4 & 4095;
          *(u32x2*)(Vt + ((long)b * 1024 + (n - 2048)) * 4096 + s) =
              pack4(v[0] * rstd_of(g.ssq_in, m4, 1.f / 1024), v[1] * rstd_of(g.ssq_in, m4 + 1, 1.f / 1024),
                    v[2] * rstd_of(g.ssq_in, m4 + 2, 1.f / 1024), v[3] * rstd_of(g.ssq_in, m4 + 3, 1.f / 1024));
        EPI_END
      } else {
        u16* dst = (u16*)((unsigned char*)g.d0 + (nt < 4 ? 0L : (nt < 8 ? SL : 3 * SL)));
        const int nb = nt < 4 ? 0 : (nt < 8 ? 1024 : 3072);
        EPI_STD_BEGIN
          const float rs = rstd_of(g.ssq_in, m, 1.f / 1024);
          *(u32x2*)(dst + (long)m * 1024 + (n4 - nb)) = pack4(v[0] * rs, v[1] * rs, v[2] * rs, v[3] * rs);
        EPI_END
      }
    } else if (MODE == M_MLA_IN) {
      const int u = (n0 >> 6) + wx;
      if (u < 10) {
        u16* dst = (u16*)g.d0 + (u < 6 ? 0L : (long)T_TOK * 384);
        const int ldd = u < 6 ? 384 : 256, nb = u < 6 ? 0 : 384;
        float* sqo = g.ssq_out + (u < 6 ? 0 : T_TOK);
#pragma unroll
        for (int j = 0; j < 8; ++j) {
          const int m = m0 + wy * 128 + j * 16 + lq;
          const float rs = rstd_of(g.ssq_in, m, 1.f / 1024);
          float sq = 0.f;
#pragma unroll
          for (int i = 0; i < 4; ++i) {
            const int n4 = n0 + wx * 64 + i * 16 + lg * 4;
            const f32x4 v = acc[i][j] * rs;
            *(u32x2*)(dst + (long)m * ldd + (n4 - nb)) = pack4(v[0], v[1], v[2], v[3]);
            sq += v[0] * v[0] + v[1] * v[1] + v[2] * v[2] + v[3] * v[3];
          }
          sq += __shfl_xor(sq, 16);
          sq += __shfl_xor(sq, 32);
          if (lg == 0) atomicAdd(sqo + m, sq);
        }
      } else if (u == 10) {
        u16* kpe = (u16*)g.d2;
#pragma unroll
        for (int j = 0; j < 8; ++j)
#pragma unroll
          for (int i = 0; i < 2; ++i) {
            const int m = m0 + wy * 128 + j * 16 + lq, pos = m & 4095;
            const float rs = rstd_of(g.ssq_in, m, 1.f / 1024);
            const int f0 = i * 16 + lg * 4;
            const f32x4 a = acc[i][j], bq = acc[i + 2][j];
            float lo[4], hi[4];
#pragma unroll
            for (int r = 0; r < 4; ++r) {
              const float2 cssn = *(const float2*)(p.rope + ((long)pos * 32 + f0 + r) * 2);
              const float x1 = a[r] * rs, x2 = bq[r] * rs;
              lo[r] = x1 * cssn.x - x2 * cssn.y;
              hi[r] = x1 * cssn.y + x2 * cssn.x;
            }
            *(u32x2*)(kpe + (long)m * 64 + f0) = pack4(lo[0], lo[1], lo[2], lo[3]);
            *(u32x2*)(kpe + (long)m * 64 + 32 + f0) = pack4(hi[0], hi[1], hi[2], hi[3]);
          }
      }
    } else if (MODE == M_MLA_UQ) {
      u16* qo = (u16*)g.d0;
      const int slab = (n0 >> 6) + wx;
      if (slab % 3 == 2) {
#pragma unroll
        for (int j = 0; j < 8; ++j)
#pragma unroll
          for (int i = 0; i < 2; ++i) {
            const int m = m0 + wy * 128 + j * 16 + lq, pos = m & 4095;
            const float rs = rstd_of(g.ssq_in, m, 1.f / 384);
            const int f0 = i * 16 + lg * 4;
            const f32x4 a = acc[i][j], bq = acc[i + 2][j];
            float lo[4], hi[4];
#pragma unroll
            for (int r = 0; r < 4; ++r) {
              const float2 cssn = *(const float2*)(p.rope + ((long)pos * 32 + f0 + r) * 2);
              const float x1 = a[r] * rs, x2 = bq[r] * rs;
              lo[r] = x1 * cssn.x - x2 * cssn.y;
              hi[r] = x1 * cssn.y + x2 * cssn.x;
            }
            *(u32x2*)(qo + (long)m * 1536 + slab * 64 + f0) = pack4(lo[0], lo[1], lo[2], lo[3]);
            *(u32x2*)(qo + (long)m * 1536 + slab * 64 + 32 + f0) = pack4(hi[0], hi[1], hi[2], hi[3]);
          }
      } else {
        EPI_STD_BEGIN
          const float rs = rstd_of(g.ssq_in, m, 1.f / 384);
          *(u32x2*)(qo + (long)m * 1536 + n4) = pack4(v[0] * rs, v[1] * rs, v[2] * rs, v[3] * rs);
        EPI_END
      }
    } else if (MODE == M_MLA_UKV) {
      if (transposed) {
        u16* Vt = (u16*)g.d1;
        EPI_TR_BEGIN
          const int b = m4 >> 12, s = m4 & 4095;
          *(u32x2*)(Vt + ((long)b * 1024 + (n - 1024)) * 4096 + s) =
              pack4(v[0] * rstd_of(g.ssq_in, m4, 1.f / 256), v[1] * rstd_of(g.ssq_in, m4 + 1, 1.f / 256),
                    v[2] * rstd_of(g.ssq_in, m4 + 2, 1.f / 256), v[3] * rstd_of(g.ssq_in, m4 + 3, 1.f / 256));
        EPI_END
      } else {
        u16* kn = (u16*)g.d0;
        EPI_STD_BEGIN
          const float rs = rstd_of(g.ssq_in, m, 1.f / 256);
          *(u32x2*)(kn + (long)m * 1024 + n4) = pack4(v[0] * rs, v[1] * rs, v[2] * rs, v[3] * rs);
        EPI_END
      }
    } else if (MODE == M_ZPASS) {
      u16* og = (u16*)g.d0;
      EPI_STD_BEGIN
        const float rs = rstd_of(g.ssq_in, m, 1.f / 1024);
        u32x2* op = (u32x2*)(og + (long)m * 1024 + n4);
        const u32x2 ov = *op;
        *op = pack4(bflo(ov.x) * silu(v[0] * rs), bfhi(ov.x) * silu(v[1] * rs), bflo(ov.y) * silu(v[2] * rs), bfhi(ov.y) * silu(v[3] * rs));
      EPI_END
    } else if (MODE == M_HG_IN) {
      if (transposed) {
        u16* iT = (u16*)g.d3;
        EPI_TR_BEGIN
          const int b = m4 >> 12, s = m4 & 4095;
          *(u32x2*)(iT + ((long)b * 1024 + (n - 3072)) * 4096 + s) =
              pack4(v[0] * rstd_of(g.ssq_in, m4, 1.f / 1024), v[1] * rstd_of(g.ssq_in, m4 + 1, 1.f / 1024),
                    v[2] * rstd_of(g.ssq_in, m4 + 2, 1.f / 1024), v[3] * rstd_of(g.ssq_in, m4 + 3, 1.f / 1024));
        EPI_END
      } else if (nt < 4) {
        u16* qo = (u16*)g.d0;
        EPI_STD_BEGIN
          const float rs = rstd_of(g.ssq_in, m, 1.f / 1024);
          *(u32x2*)(qo + (long)m * 1024 + n4) = pack4(silu(v[0] * rs), silu(v[1] * rs), silu(v[2] * rs), silu(v[3] * rs));
        EPI_END
      } else {
        const int dir = nt >= 8;
        __half* go = (__half*)((unsigned char*)g.d1 + (dir ? SL : 0L));
        EPI_STD_BEGIN
          const float rs = rstd_of(g.ssq_in, m, 1.f / 1024);
          const int c = n4 - 1024 - dir * 1024;
          const float4 lbv = *(const float4*)(p.lb + dir * 1024 + c);
          __half2 h01, h23;
          h01.x = __float2half(__logf(lbv.x + (1.f - lbv.x) * sigm(v[0] * rs)));
          h01.y = __float2half(__logf(lbv.y + (1.f - lbv.y) * sigm(v[1] * rs)));
          h23.x = __float2half(__logf(lbv.z + (1.f - lbv.z) * sigm(v[2] * rs)));
          h23.y = __float2half(__logf(lbv.w + (1.f - lbv.w) * sigm(v[3] * rs)));
          __half2* dp = (__half2*)(go + (long)m * 1024 + c);
          dp[0] = h01; dp[1] = h23;
        EPI_END
      }
    }
  }
}

DI void convert_p(const Params& p, int li, u16* dst) {
  const long gt = (long)blockIdx.x * NTHR + tid_opaque(), gn = (long)gridDim.x * NTHR;
  for (long id = gt; id < (long)T_TOK * 64; id += gn) {
    const long m = id >> 6; const int c4 = (int)(id & 63) * 4;
    const float* src = (m < TP) ? p.p_prompt + ((long)li * TP + m) * 256 : p.p_sample + ((long)li * (T_TOK - TP) + (m - TP)) * 256;
    const float4 v = *(const float4*)(src + c4);
    *(u32x2*)(dst + m * 256 + c4) = pack4(v.x, v.y, v.z, v.w);
  }
}

DI void na_phase(const Params& p, const u16* q, const u16* k, const u16* vt, const u16* z, u16* og, unsigned char* smem) {
  if (!((PH_MASK >> 10) & 1u)) return;
  const int t = tid_opaque(), l = t & 63, w = __builtin_amdgcn_readfirstlane(t >> 6), lq = l & 15, lg = l >> 4;
  const int hh = w >> 1, jb = (w & 1) * 2;
  float* rp = (float*)(smem + 131072) + hh * 480;
  constexpr int NSTG = 32768;
  int cur_hg = -1;
  for (int item = blockIdx.x; item < 20 * 64 * 8; item += gridDim.x) {
    const int hg = item & 7, r = (item >> 3) & 63, b = item >> 9;
    const int h = hg * 4 + hh;
    const int rs = min(max(r - 4, 0), 56);
    __syncthreads();
    if (hg != cur_hg) {
      if (!(w & 1)) for (int i = l; i < 465; i += 64) rp[i] = p.na_rpb[h * 465 + i];
      cur_hg = hg;
    }
    auto issue = [&](int ri) {
      const int t2 = tid_opaque();
      unsigned char* sb = smem + (ri & 3) * NSTG + t2 * 16;
      const long tok0 = (long)b * 4096 + (rs + ri) * 64;
#pragma unroll
      for (int i = 0; i < 2; ++i) {
        const int cid = t2 + 512 * i, row = cid >> 4, c = (cid & 15) ^ (row & 15);
        __builtin_amdgcn_global_load_lds((const unsigned*)(k + (tok0 + row) * 1024 + hg * 128 + c * 8), LDS_PTR(sb + i * 8192), 16, 0, 0);
      }
#pragma unroll
      for (int i = 0; i < 2; ++i) {
        const int cid = t2 + 512 * i, row = cid >> 3, c = (cid & 7) ^ ((row >> 1) & 7);
        __builtin_amdgcn_global_load_lds((const unsigned*)(vt + ((long)(b * 1024 + hg * 128 + row)) * 4096 + (rs + ri) * 64 + c * 8),
                                         LDS_PTR(sb + 16384 + i * 8192), 16, 0, 0);
      }
    };
    bf16x8 qf[2];
#pragma unroll
    for (int jj = 0; jj < 2; ++jj)
      qf[jj] = *(const bf16x8*)(q + ((long)b * 4096 + r * 64 + (jb + jj) * 16 + lq) * 1024 + h * 32 + lg * 8);
    issue(0); issue(1); issue(2);
    f32x4 o[2][2];
    float lrun[2];
#pragma unroll
    for (int jj = 0; jj < 2; ++jj) { o[jj][0] = f32x4{0.f, 0.f, 0.f, 0.f}; o[jj][1] = f32x4{0.f, 0.f, 0.f, 0.f}; lrun[jj] = 0.f; }
#pragma unroll 1
    for (int ri = 0; ri < 8; ++ri) {
      if (ri <= 5) asm volatile("s_waitcnt vmcnt(8)" ::: "memory");
      else if (ri == 6) asm volatile("s_waitcnt vmcnt(4)" ::: "memory");
      else asm volatile("s_waitcnt vmcnt(0)" ::: "memory");
      asm volatile("s_waitcnt lgkmcnt(0)" ::: "memory");
      __builtin_amdgcn_s_barrier();
      if (ri + 3 < 8) issue(ri + 3);
      const unsigned char* Ks = smem + (ri & 3) * NSTG;
      const unsigned char* Vs = Ks + 16384;
      const int ro = rs + ri - r + 7;
#pragma unroll
      for (int jj = 0; jj < 2; ++jj) {
        const int j = jb + jj;
        const int kcs = min(max(j * 16 - 8, 0), 32);
        f32x4 sc[2];
#pragma unroll
        for (int c2 = 0; c2 < 2; ++c2) {
          const int row = kcs + c2 * 16 + lq;
          const bf16x8 kf = *(const bf16x8*)(Ks + row * 256 + (((hh * 4 + lg) ^ (row & 15)) << 4));
          sc[c2] = MFMA16(kf, qf[jj], (f32x4{0.f, 0.f, 0.f, 0.f}));
        }
        const int qcol = j * 16 + lq, win = min(max(qcol - 8, 0), 48);
        float ps = 0.f;
#pragma unroll
        for (int c2 = 0; c2 < 2; ++c2)
#pragma unroll
          for (int rr = 0; rr < 4; ++rr) {
            const int kcol = kcs + c2 * 16 + lg * 4 + rr;
            const bool valid = (kcol >= win) && (kcol < win + 16);
            const int co = min(max(kcol - qcol + 15, 0), 30);
            const float e = valid ? __expf(fminf(sc[c2][rr] + rp[ro * 31 + co], 80.f)) : 0.f;
            sc[c2][rr] = e;
            ps += e;
          }
        lrun[jj] += ps;
        const bf16x8 pf = pack8(sc[0], sc[1]);
#pragma unroll
        for (int dt = 0; dt < 2; ++dt) {
          const int vrow = hh * 32 + dt * 16 + lq, vsw = (vrow >> 1) & 7, ch = (kcs >> 3) + (lg >> 1);
          const unsigned char* vr = Vs + vrow * 128 + (lg & 1) * 8;
          const s16x4 lo = *(const s16x4*)(vr + ((ch ^ vsw) << 4));
          const s16x4 hi = *(const s16x4*)(vr + (((ch + 2) ^ vsw) << 4));
          o[jj][dt] = MFMA16(cat8(lo, hi), pf, o[jj][dt]);
        }
      }
    }
#pragma unroll
    for (int jj = 0; jj < 2; ++jj) {
      float ls = lrun[jj];
      ls += __shfl_xor(ls, 16);
      ls += __shfl_xor(ls, 32);
      const float inv = __builtin_amdgcn_rcpf(ls);
#pragma unroll
      for (int dt = 0; dt < 2; ++dt) {
        const long off = ((long)b * 4096 + r * 64 + (jb + jj) * 16 + lq) * 1024 + h * 32 + dt * 16 + lg * 4;
        const u32x2 zz = *(const u32x2*)(z + off);
        *(u32x2*)(og + off) = pack4(o[jj][dt][0] * inv * silu(bflo(zz.x)), o[jj][dt][1] * inv * silu(bfhi(zz.x)),
                                    o[jj][dt][2] * inv * silu(bflo(zz.y)), o[jj][dt][3] * inv * silu(bfhi(zz.y)));
      }
    }
  }
  __syncthreads();
}

DI void mla_attn(const u16* q, const u16* kn, const u16* kpe, const u16* vt, u16* o, unsigned char* smem) {
  if (!((PH_MASK >> 11) & 1u)) return;
  const int t = tid_opaque(), l = t & 63, w = __builtin_amdgcn_readfirstlane(t >> 6), lq = l & 15, lg = l >> 4;
  const int fsw = (lq >> 1) & 7;
  constexpr int NQT = 2, QPB = 128 * NQT, NQB = 4096 / QPB, MSTAGE = 40960;
  for (int item = blockIdx.x; item < 20 * 8 * NQB; item += gridDim.x) {
    const int qb = item % NQB, h = (item / NQB) & 7, b = item / (NQB * 8);
    const long tb = (long)b * 4096;
    bf16x8 qf[NQT][6];
#pragma unroll
    for (int qt = 0; qt < NQT; ++qt)
#pragma unroll
      for (int ks = 0; ks < 6; ++ks)
        qf[qt][ks] = *(const bf16x8*)(q + (tb + qb * QPB + w * 16 * NQT + qt * 16 + lq) * 1536 + h * 192 + ks * 32 + lg * 8);
    f32x4 oacc[8][NQT];
#pragma unroll
    for (int dt = 0; dt < 8; ++dt)
#pragma unroll
      for (int qt = 0; qt < NQT; ++qt) oacc[dt][qt] = f32x4{0.f, 0.f, 0.f, 0.f};
    float mrun[NQT], lrun[NQT];
#pragma unroll
    for (int qt = 0; qt < NQT; ++qt) { mrun[qt] = -1e30f; lrun[qt] = 0.f; }
    auto issue = [&](int kt, int stage) {
      const int t2 = tid_opaque();
      unsigned char* sb = smem + stage * MSTAGE + t2 * 16;
      const long k0 = tb + kt * 64;
#pragma unroll
      for (int i = 0; i < 3; ++i) {
        const int cid = t2 + 512 * i, row = cid / 24, c = (cid - row * 24) ^ ((row >> 1) & 7);
        const u16* src = c < 16 ? kn + (k0 + row) * 1024 + h * 128 + c * 8 : kpe + (k0 + row) * 64 + (c - 16) * 8;
        __builtin_amdgcn_global_load_lds((const unsigned*)src, LDS_PTR(sb + i * 8192), 16, 0, 0);
      }
#pragma unroll
      for (int i = 0; i < 2; ++i) {
        const int cid = t2 + 512 * i, d = cid >> 3, c = (cid & 7) ^ ((d >> 1) & 7);
        __builtin_amdgcn_global_load_lds((const unsigned*)(vt + ((long)(b * 1024 + h * 128 + d)) * 4096 + kt * 64 + c * 8),
                                         LDS_PTR(sb + 24576 + i * 8192), 16, 0, 0);
      }
    };
    __syncthreads();
    issue(0, 0);
    issue(1, 1);
    int st = 0;
#pragma unroll 1
    for (int kt = 0; kt < 64; ++kt) {
      if (kt + 1 < 64) asm volatile("s_waitcnt vmcnt(5)" ::: "memory");
      else asm volatile("s_waitcnt vmcnt(0)" ::: "memory");
      __builtin_amdgcn_s_barrier();
      if (kt + 2 < 64) { int s2 = st + 2; if (s2 >= 3) s2 -= 3; issue(kt + 2, s2); }
      const unsigned char* Kt = smem + st * MSTAGE;
      const unsigned char* Vt = Kt + 24576;
      f32x4 s[4][NQT];
#pragma unroll
      for (int k16 = 0; k16 < 4; ++k16)
#pragma unroll
        for (int qt = 0; qt < NQT; ++qt) s[k16][qt] = f32x4{0.f, 0.f, 0.f, 0.f};
#pragma unroll
      for (int ks = 0; ks < 6; ++ks) {
#pragma unroll
        for (int k16 = 0; k16 < 4; ++k16) {
          const bf16x8 kf = *(const bf16x8*)(Kt + (k16 * 16 + lq) * 384 + (((ks * 4 + lg) ^ fsw) << 4));
#pragma unroll
          for (int qt = 0; qt < NQT; ++qt) s[k16][qt] = MFMA16(kf, qf[qt][ks], s[k16][qt]);
        }
        if (ks & 1) __builtin_amdgcn_sched_barrier(0);
      }
      bf16x8 pf[NQT][2];
#pragma unroll
      for (int qt = 0; qt < NQT; ++qt) {
        float ps = 0.f;
#pragma unroll
        for (int k16 = 0; k16 < 4; ++k16)
#pragma unroll
          for (int rr = 0; rr < 4; ++rr) { const float e = __builtin_amdgcn_exp2f(fminf(s[k16][qt][rr], 100.f)); s[k16][qt][rr] = e; ps += e; }
        lrun[qt] += ps;
        pf[qt][0] = pack8(s[0][qt], s[1][qt]);
        pf[qt][1] = pack8(s[2][qt], s[3][qt]);
      }
#pragma unroll
      for (int kk = 0; kk < 2; ++kk)
#pragma unroll
        for (int dt = 0; dt < 8; ++dt) {
          const unsigned char* vr = Vt + (dt * 16 + lq) * 128 + (lg & 1) * 8;
          const s16x4 lo = *(const s16x4*)(vr + (((kk * 4 + (lg >> 1)) ^ fsw) << 4));
          const s16x4 hi = *(const s16x4*)(vr + (((kk * 4 + (lg >> 1) + 2) ^ fsw) << 4));
          const bf16x8 vf = cat8(lo, hi);
#pragma unroll
          for (int qt = 0; qt < NQT; ++qt) oacc[dt][qt] = MFMA16(vf, pf[qt][kk], oacc[dt][qt]);
        }
      st = (st == 2) ? 0 : st + 1;
    }
#pragma unroll
    for (int qt = 0; qt < NQT; ++qt) {
      float ls = lrun[qt];
      ls += __shfl_xor(ls, 16);
      ls += __shfl_xor(ls, 32);
      const float inv = __builtin_amdgcn_rcpf(ls);
      const long row = (tb + qb * QPB + w * 16 * NQT + qt * 16 + lq) * 1024 + h * 128 + lg * 4;
#pragma unroll
      for (int dt = 0; dt < 8; ++dt)
        *(u32x2*)(o + row + dt * 16) = pack4(oacc[dt][qt][0] * inv, oacc[dt][qt][1] * inv, oacc[dt][qt][2] * inv, oacc[dt][qt][3] * inv);
    }
  }
}

DI u32x4 rev8(u32x4 v) {
  u32x4 r;
  r.x = (v.w >> 16) | (v.w << 16); r.y = (v.z >> 16) | (v.z << 16); r.z = (v.y >> 16) | (v.y << 16); r.w = (v.x >> 16) | (v.x << 16);
  return r;
}
DI void hg_scan(const u16* qh, const __half* gf, const __half* gb, const u16* it, const float* g_out, u16* o, unsigned char* smem) {
  if (!((PH_MASK >> 12) & 1u)) return;
  const int t = tid_opaque(), l = t & 63, w = __builtin_amdgcn_readfirstlane(t >> 6), lq = l & 15, lg = l >> 4;
  unsigned char* QT = smem;
  unsigned char* KT = smem + 16384;
  unsigned char* KH = smem + 32768;
  unsigned char* VT = smem + 49152;
  u16* RQ = (u16*)(smem + 65536);
  __half* RG = (__half*)(smem + 81920);
  float* RED = (float*)(smem + 98304);
  float* DEC = (float*)(smem + 98304 + 2048);
  float* PS = (float*)(smem + 98304 + 2048 + 512);
  const int vs = w * 16, vsw = (lq >> 1) & 7;
  const int col = t & 127, qr = t >> 7;
  for (int item = blockIdx.x; item < 160; item += gridDim.x) {
    const int b = item >> 3, h = item & 7;
    for (int dir = 0; dir < 2; ++dir) {
      const __half* gsrc = dir ? gb : gf;
      f32x4 S[8];
#pragma unroll
      for (int ct = 0; ct < 8; ++ct) S[ct] = f32x4{0.f, 0.f, 0.f, 0.f};
      u32x4 rq[2], rgv[2], rv[2];
      auto gload = [&](int step) {
        const int cidx = dir ? 63 - step : step;
        const long tok0 = (long)b * 4096 + cidx * 64;
#pragma unroll
        for (int i = 0; i < 2; ++i) {
          const int cid = t + 512 * i, row = cid >> 4, c = cid & 15;
          rq[i] = *(const u32x4*)(qh + (tok0 + row) * 1024 + h * 128 + c * 8);
          rgv[i] = *(const u32x4*)(gsrc + (tok0 + row) * 1024 + h * 128 + c * 8);
          const int vv = cid >> 3, c8 = cid & 7;
          rv[i] = *(const u32x4*)(it + ((long)(b * 1024 + h * 128 + vv)) * 4096 + cidx * 64 + c8 * 8);
        }
      };
      auto store_raw = [&]() {
#pragma unroll
        for (int i = 0; i < 2; ++i) {
          const int cid = t + 512 * i, row = cid >> 4, c = cid & 15;
          const int rw = dir ? 63 - row : row;
          *(u32x4*)((unsigned char*)RQ + rw * 256 + c * 16) = rq[i];
          *(u32x4*)((unsigned char*)RG + rw * 256 + c * 16) = rgv[i];
        }
      };
      auto store_v = [&]() {
#pragma unroll
        for (int i = 0; i < 2; ++i) {
          const int cid = t + 512 * i, vv = cid >> 3, c8 = cid & 7;
          const int cc = dir ? 7 - c8 : c8;
          *(u32x4*)(VT + vv * 128 + ((cc ^ ((vv >> 1) & 7)) << 4)) = dir ? rev8(rv[i]) : rv[i];
        }
      };
      __syncthreads();
      gload(0);
      store_raw();
      store_v();
      __syncthreads();
      for (int step = 0; step < 64; ++step) {
        const int cidx = dir ? 63 - step : step;
        const long tok0 = (long)b * 4096 + cidx * 64;
        if (step + 1 < 64) gload(step + 1);
        {
          float gvr[16];
          float psum = 0.f;
#pragma unroll
          for (int rr = 0; rr < 16; ++rr) { gvr[rr] = __half2float(RG[(qr * 16 + rr) * 128 + col]); psum += gvr[rr]; }
          PS[qr * 128 + col] = psum;
          __syncthreads();
          const float p0 = PS[col], p1 = PS[128 + col], p2 = PS[256 + col], p3 = PS[384 + col];
          const float tot = (p0 + p1) + (p2 + p3);
          const float pre = (qr > 0 ? p0 : 0.f) + (qr > 1 ? p1 : 0.f) + (qr > 2 ? p2 : 0.f);
          float eb = __expf(pre), ieb = __expf(-pre);
          const float etot = __expf(tot);
          unsigned khp[8];
#pragma unroll
          for (int rr = 0; rr < 16; ++rr) {
            const int r = qr * 16 + rr;
            const float f = __expf(gvr[rr]);
            eb *= f;
            ieb *= __builtin_amdgcn_rcpf(f);
            const float qv = bf2f(RQ[r * 128 + col]);
            const float kk = 1.f - f;
            const float kt = kk * ieb;
            const unsigned off = r * 256 + (((col >> 3) ^ (r & 15)) << 4) + (col & 7) * 2;
            *(u16*)(QT + off) = f2bf(qv * eb);
            *(u16*)(KT + off) = f2bf(kt);
            const float kh = kt * etot;
            if (rr & 1) khp[rr >> 1] = pack2(__uint_as_float(khp[rr >> 1]), kh); else khp[rr >> 1] = __float_as_uint(kh);
          }
          const int sw = (col >> 1) & 7;
          u32x4 k0, k1;
          k0.x = khp[0]; k0.y = khp[1]; k0.z = khp[2]; k0.w = khp[3];
          k1.x = khp[4]; k1.y = khp[5]; k1.z = khp[6]; k1.w = khp[7];
          *(u32x4*)(KH + col * 128 + (((qr * 2) ^ sw) << 4)) = k0;
          *(u32x4*)(KH + col * 128 + (((qr * 2 + 1) ^ sw) << 4)) = k1;
          if (qr == 0) DEC[col] = etot;
        }
        __syncthreads();
        if (step + 1 < 64) store_raw();
        __builtin_amdgcn_sched_barrier(0);
        bf16x8 Sop[4];
#pragma unroll
        for (int i = 0; i < 4; ++i) Sop[i] = pack8(S[2 * i], S[2 * i + 1]);
        f32x4 ot[4];
#pragma unroll
        for (int tt = 0; tt < 4; ++tt) {
          const unsigned char* qrow = QT + (tt * 16 + lq) * 256;
          bf16x8 qB[4];
#pragma unroll
          for (int ks = 0; ks < 4; ++ks) qB[ks] = *(const bf16x8*)(qrow + (((ks * 4 + lg) ^ lq) << 4));
          f32x4 at[4];
#pragma unroll
          for (int st = 0; st < 4; ++st) {
            at[st] = f32x4{0.f, 0.f, 0.f, 0.f};
            if (st <= tt) {
              const unsigned char* krow = KT + (st * 16 + lq) * 256;
#pragma unroll
              for (int ks = 0; ks < 4; ++ks) {
                const bf16x8 kA = *(const bf16x8*)(krow + (((ks * 4 + lg) ^ lq) << 4));
                at[st] = MFMA16(kA, qB[ks], at[st]);
              }
              if (st == tt) {
#pragma unroll
                for (int rr = 0; rr < 4; ++rr) if (lg * 4 + rr > lq) at[st][rr] = 0.f;
              }
            }
          }
          f32x4 acc = f32x4{0.f, 0.f, 0.f, 0.f};
#pragma unroll
          for (int kk = 0; kk < 2; ++kk) {
            if (2 * kk <= tt) {
              const bf16x8 pfr = pack8(at[2 * kk], at[2 * kk + 1]);
              const unsigned char* vr = VT + (vs + lq) * 128 + (lg & 1) * 8;
              const s16x4 lo = *(const s16x4*)(vr + (((kk * 4 + (lg >> 1)) ^ vsw) << 4));
              const s16x4 hi = *(const s16x4*)(vr + (((kk * 4 + (lg >> 1) + 2) ^ vsw) << 4));
              acc = MFMA16(cat8(lo, hi), pfr, acc);
            }
          }
#pragma unroll
          for (int i = 0; i < 4; ++i) {
            const unsigned char* qr8 = qrow + (lg & 1) * 8;
            const s16x4 lo = *(const s16x4*)(qr8 + (((i * 4 + (lg >> 1)) ^ lq) << 4));
            const s16x4 hi = *(const s16x4*)(qr8 + (((i * 4 + (lg >> 1) + 2) ^ lq) << 4));
            acc = MFMA16(Sop[i], cat8(lo, hi), acc);
          }
          ot[tt] = acc;
          __builtin_amdgcn_sched_barrier(0);
        }
#pragma unroll
        for (int ct = 0; ct < 8; ++ct) {
          const f32x4 dc = *(const f32x4*)(DEC + ct * 16 + lg * 4);
          f32x4 sn = S[ct] * dc;
#pragma unroll
          for (int kk = 0; kk < 2; ++kk) {
            const bf16x8 khA = *(const bf16x8*)(KH + (ct * 16 + lq) * 128 + (((kk * 4 + lg) ^ vsw) << 4));
            const bf16x8 vB = *(const bf16x8*)(VT + (vs + lq) * 128 + (((kk * 4 + lg) ^ vsw) << 4));
            sn = MFMA16(khA, vB, sn);
          }
          S[ct] = sn;
          if (ct & 1) __builtin_amdgcn_sched_barrier(0);
        }
        if (dir == 0) {
#pragma unroll
          for (int tt = 0; tt < 4; ++tt) {
            const long off = (tok0 + tt * 16 + lq) * 1024 + h * 128 + vs + lg * 4;
            *(u32x2*)(o + off) = pack4(ot[tt][0], ot[tt][1], ot[tt][2], ot[tt][3]);
          }
        } else {
#pragma unroll
          for (int tt = 0; tt < 4; ++tt) {
            const long off = (tok0 + 63 - (tt * 16 + lq)) * 1024 + h * 128 + vs + lg * 4;
            const u32x2 pv = *(const u32x2*)(o + off);
            ot[tt][0] += bflo(pv.x); ot[tt][1] += bfhi(pv.x); ot[tt][2] += bflo(pv.y); ot[tt][3] += bfhi(pv.y);
            float sq = ot[tt][0] * ot[tt][0] + ot[tt][1] * ot[tt][1] + ot[tt][2] * ot[tt][2] + ot[tt][3] * ot[tt][3];
            sq += __shfl_xor(sq, 16);
            sq += __shfl_xor(sq, 32);
            if (lg == 0) RED[w * 64 + tt * 16 + lq] = sq;
          }
          __syncthreads();
          const float4 gv = *(const float4*)(g_out + h * 128 + vs + lg * 4);
#pragma unroll
          for (int tt = 0; tt < 4; ++tt) {
            float sq = 0.f;
#pragma unroll
            for (int ww = 0; ww < 8; ++ww) sq += RED[ww * 64 + tt * 16 + lq];
            const float rs = rsqrtf(sq * (1.f / 128.f) + 1e-6f);
            const long off = (tok0 + 63 - (tt * 16 + lq)) * 1024 + h * 128 + vs + lg * 4;
            *(u32x2*)(o + off) = pack4(ot[tt][0] * rs * gv.x, ot[tt][1] * rs * gv.y, ot[tt][2] * rs * gv.z, ot[tt][3] * rs * gv.w);
          }
        }
        __syncthreads();
        if (step + 1 < 64) store_v();
      }
    }
  }
}

DI void final_norm(const Params& p) {
  const int tt_ = tid_opaque();
  const int l = tt_ & 63, gw = blockIdx.x * 8 + (tt_ >> 6), nw = gridDim.x * 8;
  for (int row = gw; row < T_TOK; row += nw) {
    float4* xp = (float4*)(p.out + (long)row * 1024);
    float4 v[4];
    float s = 0.f;
#pragma unroll
    for (int i = 0; i < 4; ++i) {
      v[i] = xp[l + 64 * i];
      s += v[i].x * v[i].x + v[i].y * v[i].y + v[i].z * v[i].z + v[i].w * v[i].w;
    }
#pragma unroll
    for (int o = 1; o < 64; o <<= 1) s += __shfl_xor(s, o);
    const float rs = rsqrtf(s * (1.f / 1024.f) + 1e-6f);
#pragma unroll
    for (int i = 0; i < 4; ++i) {
      const float4 g = ((const float4*)p.final_g)[l + 64 * i];
      v[i].x *= rs * g.x; v[i].y *= rs * g.y; v[i].z *= rs * g.z; v[i].w *= rs * g.w;
      xp[l + 64 * i] = v[i];
    }
  }
}

struct GSync { unsigned* bar; unsigned k; };
DI void gsync(GSync& gs) { cg::this_grid().sync(); }

DI void run_out_ple(const Params& p, GSync& gs, int li, u16* og, u16* x1b, u16* xb_out, const u16* Wout, unsigned char* smem) {
  GP g{};
  g.A = og; g.lda = 1024; g.W = Wout; g.K = 1024; g.ntn = 4; g.ntiles = 320 * 4; g.d0 = x1b; g.li = li;
  gemm_phase<M_OUT>(p, g, smem);
  convert_p(p, li, (u16*)p.proj);
  gsync(gs);
  GP g2{};
  g2.A = x1b; g2.lda = 1024; g2.W = p.Wg + (long)li * 1024 * 1024; g2.K = 1024; g2.ntn = 4; g2.ntiles = 320 * 4;
  g2.d0 = xb_out; g2.d1 = p.proj; g2.ssq_out = p.ssq + (long)(li + 1) * T_TOK; g2.W2 = p.Wp + (long)li * 1024 * 256; g2.li = li;
  gemm_phase<M_PLE>(p, g2, smem);
  gsync(gs);
}

__global__ void __launch_bounds__(NTHR) fwd_megakernel(Params p) {
  __shared__ __attribute__((aligned(16))) unsigned char smem[SMEM_BYTES];
  cg::grid_group grid = cg::this_grid();
  GSync gs{p.bar, 0u};
  if ((PH_MASK >> 13) & 1u) {
  prep_rows(p);
  prep_transposes(p, smem);
  prep_misc(p);
  }
  grid.sync();
  if ((PH_MASK >> 13) & 1u) prep_wprime(p);
  gsync(gs);
  unsigned char* P = p.proj;
  {
    GP g{};
    g.A = p.buf0; g.lda = 1024; g.W = p.Wfn; g.K = 1024; g.ntn = 12; g.ntiles = 320 * 12;
    g.d0 = P; g.d1 = P + 2 * SL; g.ssq_in = p.ssq;
    gemm_phase<M_FN_IN>(p, g, smem);
    gsync(gs);
    GP f1{};
    f1.A = (const u16*)P; f1.W = (const u16*)(P + 3 * SL); f1.K = 128; f1.ntn = 1; f1.ntiles = 5120;
    f1.d0 = p.buf0; f1.d1 = (P + 3 * SL + 2 * 256 * 128 * 2);
    gemm_phase<M_FFT1>(p, f1, smem);
    gsync(gs);
    GP f3{};
    f3.A = p.buf0; f3.W = (const u16*)(P + 3 * SL) + 256 * 128; f3.K = 128; f3.ntn = 1; f3.ntiles = 5120;
    f3.d0 = P + SL; f3.d1 = P + 2 * SL;
    gemm_phase<M_FFT3>(p, f3, smem);
    gsync(gs);
    run_out_ple(p, gs, 0, (u16*)(P + SL), p.buf0, p.buf1, p.Wfn_out, smem);
  }
  {
    GP g{};
    g.A = p.buf1; g.lda = 1024; g.W = p.Wna; g.K = 1024; g.ntn = 16; g.ntiles = 320 * 16;
    g.d0 = P; g.d1 = P + SL; g.d2 = P + 2 * SL; g.d3 = P + 3 * SL; g.ssq_in = p.ssq + T_TOK;
    gemm_phase<M_NA_IN>(p, g, smem);
    gsync(gs);
    na_phase(p, (const u16*)P, (const u16*)(P + SL), (const u16*)(P + 2 * SL), (const u16*)(P + 3 * SL), p.buf0, smem);
    gsync(gs);
    run_out_ple(p, gs, 1, p.buf0, p.buf1, p.buf0, p.Wna_out, smem);
  }
  {
    u16* cq = p.buf1; u16* ckv = p.buf1 + (long)T_TOK * 384;
    u16* qo = (u16*)P; u16* kn = (u16*)(P + SL + SL / 2); u16* vt = (u16*)(P + 2 * SL + SL / 2); u16* kpe = (u16*)(P + 3 * SL + SL / 2);
    GP g{};
    g.A = p.buf0; g.lda = 1024; g.W = p.Wmla_in; g.K = 1024; g.ntn = 3; g.ntiles = 320 * 3;
    g.d0 = cq; g.d1 = ckv; g.d2 = kpe; g.ssq_in = p.ssq + 2L * T_TOK; g.ssq_out = p.ssq_q; g.ssq_out2 = p.ssq_kv;
    gemm_phase<M_MLA_IN>(p, g, smem);
    gsync(gs);
    GP u{};
    u.A = cq; u.lda = 384; u.W = p.Wuq; u.K = 384; u.ntn = 6; u.ntiles = 320 * 6; u.d0 = qo; u.ssq_in = p.ssq_q;
    gemm_phase<M_MLA_UQ>(p, u, smem);
    GP v{};
    v.A = ckv; v.lda = 256; v.W = p.Wukv; v.K = 256; v.ntn = 8; v.ntiles = 320 * 8; v.d0 = kn; v.d1 = vt; v.ssq_in = p.ssq_kv;
    gemm_phase<M_MLA_UKV>(p, v, smem);
    gsync(gs);
    mla_attn(qo, kn, kpe, vt, p.buf1, smem);
    gsync(gs);
    GP z{};
    z.A = p.buf0; z.lda = 1024; z.W = p.Wmla_z; z.K = 1024; z.ntn = 4; z.ntiles = 320 * 4; z.d0 = p.buf1; z.ssq_in = p.ssq + 2L * T_TOK;
    gemm_phase<M_ZPASS>(p, z, smem);
    gsync(gs);
    run_out_ple(p, gs, 2, p.buf1, p.buf0, p.buf1, p.Wmla_out, smem);
  }
  {
    GP g{};
    g.A = p.buf1; g.lda = 1024; g.W = p.Whg; g.K = 1024; g.ntn = 16; g.ntiles = 320 * 16;
    g.d0 = P; g.d1 = P + SL; g.d2 = P + 2 * SL; g.d3 = P + 3 * SL; g.ssq_in = p.ssq + 3L * T_TOK;
    gemm_phase<M_HG_IN>(p, g, smem);
    gsync(gs);
    hg_scan((const u16*)P, (const __half*)(P + SL), (const __half*)(P + 2 * SL), (const u16*)(P + 3 * SL), p.hg_g_out, p.buf0, smem);
    gsync(gs);
    GP z{};
    z.A = p.buf1; z.lda = 1024; z.W = p.Whg_z; z.K = 1024; z.ntn = 4; z.ntiles = 320 * 4; z.d0 = p.buf0; z.ssq_in = p.ssq + 3L * T_TOK;
    gemm_phase<M_ZPASS>(p, z, smem);
    gsync(gs);
    run_out_ple(p, gs, 3, p.buf0, p.buf1, p.buf0, p.Whg_out, smem);
  }
  final_norm(p);
}

extern "C" void kernel_launch(void* const* d_in, const int* in_sizes, int n_in, void* d_out, int out_size,
                              void* d_ws, size_t ws_size, hipStream_t stream) {
  static int grid_blocks = 0;
  if (!grid_blocks) {
    int dev = 0, cus = 0, per_cu = 0;
    hipGetDevice(&dev);
    hipDeviceGetAttribute(&cus, hipDeviceAttributeMultiprocessorCount, dev);
    hipOccupancyMaxActiveBlocksPerMultiprocessor(&per_cu, fwd_megakernel, NTHR, 0);
    if (per_cu < 1) per_cu = 1;
    if (per_cu > 1) per_cu = 1;
    grid_blocks = cus * per_cu;
  }
  Params p;
  memset(&p, 0, sizeof(p));
  const float* const* in = (const float* const*)d_in;
  p.x_prompt = in[0]; p.x_sample = in[1]; p.p_prompt = in[2]; p.p_sample = in[3]; p.norm_g = in[4];
  p.fn_w_in = in[5]; p.fn_w_mix = in[6]; p.na_rpb = in[9]; p.hg_lb_raw = in[18]; p.hg_g_out = in[19]; p.final_g = in[23];
  const float* fn_w_out = in[7]; const float* na_w_in = in[8]; const float* na_w_out = in[10];
  const float* mla_w_in = in[11]; const float* mla_g_q = in[12]; const float* mla_w_uq = in[13];
  const float* mla_g_kv = in[14]; const float* mla_w_ukv = in[15]; const float* mla_w_out = in[16];
  const float* hg_w_in = in[17]; const float* hg_w_out = in[20]; const float* ple_w = in[21]; const float* ple_gate_w = in[22];
  p.out = (float*)d_out;
  unsigned char* ws = (unsigned char*)d_ws;
  size_t off = 0;
  auto take = [&](size_t bytes) { unsigned char* r = ws + off; off += (bytes + 255) & ~(size_t)255; return r; };
  p.buf0 = (u16*)take(SL); p.buf1 = (u16*)take(SL); p.proj = take(4 * SL);
  p.Wfn = (u16*)take(3072L * 1024 * 2); p.Wfn_out = (u16*)take(1024L * 1024 * 2);
  p.Wna = (u16*)take(4096L * 1024 * 2); p.Wna_out = (u16*)take(1024L * 1024 * 2);
  p.Wmla_in = (u16*)take(768L * 1024 * 2); p.Wmla_z = (u16*)take(1024L * 1024 * 2);
  p.Wuq = (u16*)take(1536L * 384 * 2); p.Wukv = (u16*)take(2048L * 256 * 2); p.Wmla_out = (u16*)take(1024L * 1024 * 2);
  p.Whg = (u16*)take(4096L * 1024 * 2); p.Whg_z = (u16*)take(1024L * 1024 * 2); p.Whg_out = (u16*)take(1024L * 1024 * 2);
  p.Wp = (u16*)take(4L * 1024 * 256 * 2); p.Wg = (u16*)take(4L * 1024 * 1024 * 2);
  p.CW = (float*)take(8L * 128 * 256 * 4); p.rope = (float*)take(4096L * 32 * 2 * 4);
  p.ssq = (float*)take(5L * T_TOK * 4); p.ssq_q = (float*)take((long)T_TOK * 4); p.ssq_kv = (float*)take((long)T_TOK * 4);
  p.lb = (float*)take(2048 * 4);
  p.bar = (unsigned*)take(256);
  if (off > ws_size) { fprintf(stderr, "workspace too small: need %zu have %zu\n", off, ws_size); return; }
  int nj = 0, tiles = 0;
  auto job = [&](const float* src, const float* g, u16* dst, int ld, int col0, int K, int N, float scale) {
    TJob& j = p.jobs[nj++];
    j.src = src; j.g = g; j.dst = dst; j.ld = ld; j.col0 = col0; j.K = K; j.N = N; j.scale = scale; j.tile0 = tiles;
    tiles += (K / 64) * (N / 64);
  };
  const float* ng = p.norm_g;
  job(p.fn_w_in, ng, p.Wfn + 2048L * 1024, 2048, 1024, 1024, 1024, 1.f);
  job(fn_w_out, nullptr, p.Wfn_out, 1024, 0, 1024, 1024, 1.f);
  job(na_w_in, ng + 1024, p.Wna, 4096, 0, 1024, 1024, 0.17677669529663687f);
  job(na_w_in, ng + 1024, p.Wna + 1024L * 1024, 4096, 1024, 1024, 3072, 1.f);
  job(na_w_out, nullptr, p.Wna_out, 1024, 0, 1024, 1024, 1.f);
  job(mla_w_in, ng + 2048, p.Wmla_in, 1728, 0, 1024, 704, 1.f);
  job(mla_w_in, ng + 2048, p.Wmla_z, 1728, 704, 1024, 1024, 1.f);
  job(mla_w_uq, mla_g_q, p.Wuq, 1536, 0, 384, 1536, 0.07216878364870322f * 1.4426950408889634f);
  for (int h = 0; h < 8; ++h)
    for (int part = 0; part < 2; ++part)
      job(mla_w_ukv, mla_g_kv, p.Wukv + (long)(part * 1024 + h * 128) * 256, 2048, h * 256 + part * 128, 256, 128, 1.f);
  job(mla_w_out, nullptr, p.Wmla_out, 1024, 0, 1024, 1024, 1.f);
  job(hg_w_in, ng + 3072, p.Whg, 5120, 0, 1024, 4096, 1.f);
  job(hg_w_in, ng + 3072, p.Whg_z, 5120, 4096, 1024, 1024, 1.f);
  job(hg_w_out, nullptr, p.Whg_out, 1024, 0, 1024, 1024, 1.f);
  for (int li = 0; li < 4; ++li) job(ple_w + (long)li * 256 * 1024, nullptr, p.Wp + (long)li * 1024 * 256, 1024, 0, 256, 1024, 1.f);
  for (int li = 0; li < 4; ++li) job(ple_gate_w + (long)li * 1024 * 1024, nullptr, p.Wg + (long)li * 1024 * 1024, 1024, 0, 1024, 1024, 1.f);
  p.njobs = nj; p.ntjt = tiles;
  void* args[] = {&p};
  hipError_t e = hipLaunchCooperativeKernel((void*)fwd_megakernel, dim3(grid_blocks), dim3(NTHR), args, 0, stream);
  if (e != hipSuccess) fprintf(stderr, "cooperative launch failed: %s (grid %d)\n", hipGetErrorString(e), grid_blocks);
}
```

```cpp
#include <hip/hip_runtime.h>
#include <hip/hip_fp16.h>
#include <hip/hip_cooperative_groups.h>
#include <cstdio>
#include <cstring>
namespace cg = cooperative_groups;

#define DI __device__ __forceinline__
typedef unsigned short u16;
typedef __attribute__((ext_vector_type(8))) short bf16x8;
typedef __attribute__((ext_vector_type(4))) short s16x4;
typedef __attribute__((ext_vector_type(4))) float f32x4;
typedef __attribute__((ext_vector_type(4))) unsigned u32x4;
typedef __attribute__((ext_vector_type(2))) unsigned u32x2;

constexpr int T_TOK = 81920;
constexpr int TP = 16384;
constexpr long SL = (long)T_TOK * 1024 * 2;
constexpr int NTHR = 512;
constexpr int SMEM_BYTES = 147456;

#define MFMA16(a, b, c) __builtin_amdgcn_mfma_f32_16x16x32_bf16((a), (b), (c), 0, 0, 0)

DI int tid_opaque() { int t = threadIdx.x; asm volatile("" : "+v"(t)); return t; }
typedef __attribute__((ext_vector_type(2))) __bf16 bf16x2_t;
typedef __attribute__((ext_vector_type(2))) float f32x2_t;
DI unsigned pack2(float a, float b) { f32x2_t v = {a, b}; return __builtin_bit_cast(unsigned, __builtin_convertvector(v, bf16x2_t)); }
DI u16 f2bf(float x) { return (u16)(pack2(x, 0.f) & 0xffffu); }
DI float bf2f(u16 v) { return __uint_as_float(((unsigned)v) << 16); }
DI float bflo(unsigned u) { return __uint_as_float(u << 16); }
DI float bfhi(unsigned u) { return __uint_as_float(u & 0xffff0000u); }
DI float sigm(float v) { return __builtin_amdgcn_rcpf(1.f + __expf(-v)); }
DI float silu(float v) { return v * __builtin_amdgcn_rcpf(1.f + __expf(-v)); }
DI u32x2 pack4(float a, float b, float c, float d) { u32x2 r; r.x = pack2(a, b); r.y = pack2(c, d); return r; }
DI bf16x8 pack8(f32x4 a, f32x4 b) {
  u32x4 r; r.x = pack2(a[0], a[1]); r.y = pack2(a[2], a[3]); r.z = pack2(b[0], b[1]); r.w = pack2(b[2], b[3]);
  return __builtin_bit_cast(bf16x8, r);
}
DI bf16x8 cat8(s16x4 lo, s16x4 hi) { return __builtin_shufflevector(lo, hi, 0, 1, 2, 3, 4, 5, 6, 7); }

struct TJob { const float* src; const float* g; u16* dst; int ld; int col0; int K; int N; float scale; int tile0; };

struct Params {
  const float *x_prompt, *x_sample, *p_prompt, *p_sample, *norm_g, *fn_w_in, *fn_w_mix, *na_rpb, *hg_lb_raw, *hg_g_out, *final_g;
  float* out;
  u16 *buf0, *buf1;
  unsigned char* proj;
  u16 *Wfn, *Wfn_out, *Wna, *Wna_out, *Wmla_in, *Wmla_z, *Wuq, *Wukv, *Wmla_out, *Whg, *Whg_z, *Whg_out, *Wp, *Wg;
  float *CW, *rope, *ssq, *ssq_q, *ssq_kv, *lb;
  unsigned* bar;
  int njobs, ntjt;
  TJob jobs[40];
};

#define LDS_PTR(p) ((__attribute__((address_space(3))) unsigned*)(p))
template <int PIPE>
DI void gemm_loop_g(const u16* __restrict__ Xp, long ldx_l, long ldx_i, long kxs,
                    const u16* __restrict__ Yp, long ldy_l, long ldy_i, long kys, int K,
                    f32x4 (&acc)[4][8], unsigned char* smem) {
  const int t = tid_opaque(), l = t & 63, w = __builtin_amdgcn_readfirstlane(t >> 6), wx = w >> 1, wy = w & 1;
  const int lrow = t >> 3, gch = (t & 7) ^ ((t >> 4) & 7);
  const u16* xs = Xp + (long)lrow * ldx_l + gch * 8;
  const u16* ys = Yp + (long)lrow * ldy_l + gch * 8;
  const int fsw = (l >> 1) & 7, lg = l >> 4;
  const unsigned fr0 = (l & 15) * 128 + ((lg ^ fsw) << 4);
  const unsigned fr1 = (l & 15) * 128 + (((lg + 4) ^ fsw) << 4);
  const unsigned ub = wx * 8192, vb = 32768 + wy * 16384;
  const int nk = K >> 6;
  const int rot = (int)((blockIdx.x >> 3) + (blockIdx.x & 7) * 5) % nk;
  auto issue = [&](int kt0, int stage) {
    int kt = kt0 + rot; if (kt >= nk) kt -= nk;
    unsigned char* sb = smem + stage * 65536 + t * 16;
#pragma unroll
    for (int i = 0; i < 4; ++i)
      __builtin_amdgcn_global_load_lds((const unsigned*)(xs + i * ldx_i + kt * kxs), LDS_PTR(sb + i * 8192), 16, 0, 0);
#pragma unroll
    for (int i = 0; i < 4; ++i)
      __builtin_amdgcn_global_load_lds((const unsigned*)(ys + i * ldy_i + kt * kys), LDS_PTR(sb + 32768 + i * 8192), 16, 0, 0);
  };
  __syncthreads();
  issue(0, 0);
  asm volatile("s_waitcnt vmcnt(0)" ::: "memory");
  __syncthreads();
#pragma unroll 1
  for (int kt = 0; kt < nk; ++kt) {
    const unsigned char* cur = smem + (kt & 1) * 65536;
    if (kt + 1 < nk) issue(kt + 1, (kt + 1) & 1);
    if (PIPE) {
      bf16x8 u0[4], u1[4], vf[8];
#pragma unroll
      for (int i = 0; i < 4; ++i) u0[i] = *(const bf16x8*)(cur + ub + i * 2048 + fr0);
#pragma unroll
      for (int j = 0; j < 8; ++j) vf[j] = *(const bf16x8*)(cur + vb + j * 2048 + fr0);
#pragma unroll
      for (int j = 0; j < 8; ++j) {
#pragma unroll
        for (int i = 0; i < 4; ++i) acc[i][j] = MFMA16(u0[i], vf[j], acc[i][j]);
        vf[j] = *(const bf16x8*)(cur + vb + j * 2048 + fr1);
        if (j < 4) u1[j] = *(const bf16x8*)(cur + ub + j * 2048 + fr1);
        if (j & 1) __builtin_amdgcn_sched_barrier(0);
      }
#pragma unroll
      for (int j = 0; j < 8; ++j)
#pragma unroll
        for (int i = 0; i < 4; ++i) acc[i][j] = MFMA16(u1[i], vf[j], acc[i][j]);
    }
    else {
#pragma unroll
      for (int ks = 0; ks < 2; ++ks) {
        const unsigned fr = ks ? fr1 : fr0;
        bf16x8 uf[4], vf[8];
#pragma unroll
        for (int i = 0; i < 4; ++i) uf[i] = *(const bf16x8*)(cur + ub + i * 2048 + fr);
#pragma unroll
        for (int j = 0; j < 8; ++j) vf[j] = *(const bf16x8*)(cur + vb + j * 2048 + fr);
#pragma unroll
        for (int i = 0; i < 4; ++i)
#pragma unroll
          for (int j = 0; j < 8; ++j) acc[i][j] = MFMA16(uf[i], vf[j], acc[i][j]);
      }
    }
    asm volatile("s_waitcnt vmcnt(0)" ::: "memory");
    __syncthreads();
  }
}

DI void gemm_loop(const u16* __restrict__ Xp, long ldx, const u16* __restrict__ Yp, long ldy, int K,
                  f32x4 (&acc)[4][8], unsigned char* smem) {
  gemm_loop_g<1>(Xp, ldx, 64 * ldx, 64, Yp, ldy, 64 * ldy, 64, K, acc, smem);
}

DI void zero_acc(f32x4 (&acc)[4][8]) {
#pragma unroll
  for (int i = 0; i < 4; ++i)
#pragma unroll
    for (int j = 0; j < 8; ++j) acc[i][j] = f32x4{0.f, 0.f, 0.f, 0.f};
}

#define EPI_STD_BEGIN                                                        \
  _Pragma("unroll") for (int j = 0; j < 8; ++j) _Pragma("unroll") for (int i = 0; i < 4; ++i) { \
    const int n4 = n0 + wx * 64 + i * 16 + lg * 4;                           \
    const int m = m0 + wy * 128 + j * 16 + lq;                               \
    const f32x4 v = acc[i][j];
#define EPI_TR_BEGIN                                                         \
  _Pragma("unroll") for (int j = 0; j < 8; ++j) _Pragma("unroll") for (int i = 0; i < 4; ++i) { \
    const int m4 = m0 + wx * 64 + i * 16 + lg * 4;                           \
    const int n = n0 + wy * 128 + j * 16 + lq;                               \
    const f32x4 v = acc[i][j];
#define EPI_END if (i == 3 && (j & 3) == 3) __builtin_amdgcn_sched_barrier(0); }

DI float rstd_of(const float* ssq, int m, float invn) { return rsqrtf(ssq[m] * invn + 1e-6f); }

DI void prep_rows(const Params& p) {
  const int tt_ = tid_opaque();
  const int l = tt_ & 63, gw = blockIdx.x * 8 + (tt_ >> 6), nw = gridDim.x * 8;
  for (int row = gw; row < T_TOK; row += nw) {
    const float* src = row < TP ? p.x_prompt + (long)row * 1024 : p.x_sample + (long)(row - TP) * 1024;
    float4 v[4];
    float s = 0.f;
#pragma unroll
    for (int i = 0; i < 4; ++i) {
      v[i] = ((const float4*)src)[l + 64 * i];
      s += v[i].x * v[i].x + v[i].y * v[i].y + v[i].z * v[i].z + v[i].w * v[i].w;
    }
#pragma unroll
    for (int o = 1; o < 64; o <<= 1) s += __shfl_xor(s, o);
#pragma unroll
    for (int i = 0; i < 4; ++i) {
      *(u32x2*)(p.buf0 + (long)row * 1024 + (l + 64 * i) * 4) = pack4(v[i].x, v[i].y, v[i].z, v[i].w);
    }
    if (l == 0) p.ssq[row] = s;
  }
}

DI void prep_transposes(const Params& p, unsigned char* smem) {
  float* ts = (float*)smem;
  const int t = tid_opaque();
  for (int id = blockIdx.x; id < p.ntjt; id += gridDim.x) {
    int ji = 0;
    while (ji + 1 < p.njobs && id >= p.jobs[ji + 1].tile0) ++ji;
    const TJob jb = p.jobs[ji];
    const int loc = id - jb.tile0, tn_n = jb.N >> 6;
    const int tk = loc / tn_n, tn = loc - tk * tn_n;
    {
      const int r = t >> 4, c4 = (t & 15) * 4;
#pragma unroll
      for (int hh = 0; hh < 2; ++hh) {
        const int k = tk * 64 + r + 32 * hh;
        float4 v = *(const float4*)(jb.src + (long)k * jb.ld + jb.col0 + tn * 64 + c4);
        const float gk = jb.g ? jb.g[k] * jb.scale : jb.scale;
        float* d = ts + (r + 32 * hh) * 65 + c4;
        d[0] = v.x * gk; d[1] = v.y * gk; d[2] = v.z * gk; d[3] = v.w * gk;
      }
    }
    __syncthreads();
    {
      const int n = t >> 3, k8 = (t & 7) * 8;
      u32x4 o;
      o.x = pack2(ts[(k8 + 0) * 65 + n], ts[(k8 + 1) * 65 + n]);
      o.y = pack2(ts[(k8 + 2) * 65 + n], ts[(k8 + 3) * 65 + n]);
      o.z = pack2(ts[(k8 + 4) * 65 + n], ts[(k8 + 5) * 65 + n]);
      o.w = pack2(ts[(k8 + 6) * 65 + n], ts[(k8 + 7) * 65 + n]);
      *(u32x4*)(jb.dst + (long)(tn * 64 + n) * jb.K + tk * 64 + k8) = o;
    }
    __syncthreads();
  }
}

DI void prep_misc(const Params& p, unsigned char* smem) {
  const long gt = (long)blockIdx.x * NTHR + tid_opaque(), gn = (long)gridDim.x * NTHR;
  {
    u16* F2 = (u16*)(p.proj + 3 * SL); u16* G = F2 + 256 * 128; float* tw = (float*)(G + 256 * 128);
    for (long id = gt; id < 256L * 128; id += gn) {
      const int row = (int)(id >> 7), kk = (int)(id & 127), b = kk & 63, hi = kk >> 6;
      float f2 = 0.f, gg = 0.f;
      if (row < 128) {
        const int v = row & 63, im = row >> 6;
        float sn, cs;
        sincospif((float)((v * b) & 63) * (1.f / 32.f), &sn, &cs);
        f2 = (im ? (hi ? cs : sn) : (hi ? -sn : cs)) * 0.125f;
        if (row < 64) gg = (hi ? -sn : cs) * 0.125f;
      }
      F2[id] = f2bf(f2); G[id] = f2bf(gg);
    }
    for (long id = gt; id < 4096; id += gn) {
      const int v = (int)(id >> 6), a = (int)(id & 63);
      float sn, cs;
      sincospif((float)(v * a) * (1.f / 2048.f), &sn, &cs);
      tw[id * 2] = cs; tw[id * 2 + 1] = sn;
    }
  }
  for (long id = gt; id < 4096L * 32; id += gn) {
    const int pos = (int)(id >> 5), i = (int)(id & 31);
    const double inv = pow(10000.0, -(double)i / 32.0);
    double sn, cs;
    sincos((double)pos * inv, &sn, &cs);
    p.rope[id * 2] = (float)cs; p.rope[id * 2 + 1] = (float)sn;
  }
  float2* cst = (float2*)smem;
  __syncthreads();
  {
    const int tl = tid_opaque();
    if (tl < 128) { float sn, cs; sincospif((float)tl * (1.f / 64.f), &sn, &cs); cst[tl] = float2{cs, sn}; }
  }
  __syncthreads();
  for (long id = gt; id < 8L * 128 * 256; id += gn) {
    const int col = (int)(id & 255), c = (int)((id >> 8) & 127), g = (int)(id >> 15);
    const int d = col & 127, is_sin = col >> 7;
    float a = 0.f;
    for (int lq = 0; lq < 128; ++lq) {
      const float2 t2 = cst[(lq * c) & 127];
      a += (is_sin ? t2.y : t2.x) * p.fn_w_mix[((long)g * 128 + lq) * 128 + d];
    }
    p.CW[id] = a * 0.08838834764831845f;
  }
  __syncthreads();
  for (long id = gt; id < 2048; id += gn) {
    float r0 = p.hg_lb_raw[id], r1 = p.hg_lb_raw[2048 + id], r2 = p.hg_lb_raw[4096 + id], r3 = p.hg_lb_raw[6144 + id];
    float mx = fmaxf(fmaxf(r0, r1), fmaxf(r2, r3));
    float e0 = __expf(r0 - mx), e1 = __expf(r1 - mx), e2 = __expf(r2 - mx), e3 = __expf(r3 - mx);
    p.lb[id] = (e1 + e2 + e3) / (e0 + e1 + e2 + e3);
  }
  for (long id = gt; id < 4L * T_TOK; id += gn) p.ssq[T_TOK + id] = 0.f;
  for (long id = gt; id < T_TOK; id += gn) { p.ssq_q[id] = 0.f; p.ssq_kv[id] = 0.f; }
  for (long id = gt; id < 64L * 1024; id += gn) p.Wmla_in[704L * 1024 + id] = 0;
}

DI void prep_wprime(const Params& p) {
  const long gt = (long)blockIdx.x * NTHR + tid_opaque(), gn = (long)gridDim.x * NTHR;
  for (long id = gt; id < 2048L * 1024; id += gn) {
    const int k = (int)(id & 1023), np = (int)(id >> 10), g = np >> 8, col = np & 255;
    const float4* wi = (const float4*)(p.fn_w_in + (long)k * 2048 + g * 128);
    const float* cw = p.CW + (long)g * 128 * 256 + col;
    float a = 0.f;
    for (int c4 = 0; c4 < 32; ++c4) {
      float4 v = wi[c4];
      a += v.x * cw[(c4 * 4 + 0) * 256] + v.y * cw[(c4 * 4 + 1) * 256] + v.z * cw[(c4 * 4 + 2) * 256] + v.w * cw[(c4 * 4 + 3) * 256];
    }
    p.Wfn[id] = f2bf(a * p.norm_g[k]);
  }
}

enum { M_FN_IN, M_SEQ, M_OUT, M_PLE, M_NA_IN, M_MLA_IN, M_MLA_UQ, M_MLA_UKV, M_ZPASS, M_HG_IN, M_FFT1 = 14, M_FFT3 = 15 };

struct GP {
  const u16* A; long lda; const u16* W; int K; int ntn; int ntiles;
  void *d0, *d1, *d2, *d3;
  const float* ssq_in; float* ssq_out; float* ssq_out2;
  const u16* W2; int li;
};

#ifndef PH_MASK
#define PH_MASK 0xffffffffu
#endif
template <int MODE>
DI void gemm_phase(const Params& p, const GP& g, unsigned char* smem) {
  if (!((PH_MASK >> MODE) & 1u)) return;
  const int t = tid_opaque(), l = t & 63, w = __builtin_amdgcn_readfirstlane(t >> 6), wx = w >> 1, wy = w & 1, lq = l & 15, lg = l >> 4;
  const int xcd = blockIdx.x & 7, slot = blockIdx.x >> 3, nslot = gridDim.x >> 3;
  const int nent = (g.ntiles >> 3);
  for (int e = slot; e < nent; e += nslot) {
    int mt, nt;
    const u16* Ab = g.A; const u16* Wb = g.W;
    int bsel = 0;
    {
      const int ml = e / g.ntn;
      nt = e - ml * g.ntn;
      mt = xcd + 8 * ml;
    }
    if (MODE == M_SEQ) { bsel = mt >> 4; mt &= 15; Wb = g.W + (long)bsel * 1024 * 8192; }
    const int m0 = mt * 256, n0 = nt * 256;
    f32x4 acc[4][8];
    zero_acc(acc);
    int transposed = 0;
    if (MODE == M_FN_IN) transposed = nt < 8;
    if (MODE == M_NA_IN) transposed = (nt >= 8 && nt < 12);
    if (MODE == M_MLA_UKV) transposed = nt >= 4;
    if (MODE == M_HG_IN) transposed = nt >= 12;
    if (MODE == M_PLE) {
      const u16* pb = (const u16*)g.d1;
      gemm_loop(g.W2 + (long)n0 * 256, 256, pb + (long)m0 * 256, 256, 256, acc, smem);
      u16* xb = (u16*)g.d0;
      EPI_STD_BEGIN
        *(u32x2*)(xb + (long)m * 1024 + n4) = pack4(v[0], v[1], v[2], v[3]);
      EPI_END
      zero_acc(acc);
    }
    if (MODE == M_FFT1) {
      const int bt = mt >> 8, cg = mt & 255;
      gemm_loop_g<0>(Ab + ((long)(bt * 1024 + cg * 4)) * 8192, 64, 8192, 4096, Wb, 128, 64 * 128, 64, 128, acc, smem);
    } else if (MODE == M_FFT3) {
      const int bt = mt >> 8, v = (mt >> 2) & 63, cq = mt & 3;
      gemm_loop(Ab + (((long)(bt * 64 + v)) * 1024 + cq * 256) * 128, 128, Wb, 128, 128, acc, smem);
    } else if (MODE == M_FN_IN && transposed) {
      const u16* Ap = Ab + ((long)(mt >> 4) * 4096 + (mt & 15) * 4) * g.lda;
      gemm_loop_g<1>(Ap, 64 * g.lda, g.lda, 64, Wb + (long)n0 * g.K, g.K, 64L * g.K, 64, g.K, acc, smem);
    } else {
      const u16* Ap = Ab + (long)m0 * g.lda; const u16* Wp = Wb + (long)n0 * g.K;
      if (transposed) gemm_loop(Ap, g.lda, Wp, g.K, g.K, acc, smem);
      else gemm_loop(Wp, g.K, Ap, g.lda, g.K, acc, smem);
    }

    if (MODE == M_FN_IN) {
      if (transposed) {
        u16* Pt = (u16*)g.d0;
        const int bt = mt >> 4, a = (mt & 15) * 4 + wx;
        EPI_TR_BEGIN
          const int grp = n >> 8, half = (n >> 7) & 1, c = grp * 128 + (n & 127);
          const int b0 = i * 16 + lg * 4;
          const int tok = bt * 4096 + a + 64 * b0;
          (void)m4;
          *(u32x2*)(Pt + (((long)bt * 1024 + c) * 2 + half) * 4096 + a * 64 + b0) =
              pack4(v[0] * rstd_of(g.ssq_in, tok, 1.f / 1024), v[1] * rstd_of(g.ssq_in, tok + 64, 1.f / 1024),
                    v[2] * rstd_of(g.ssq_in, tok + 128, 1.f / 1024), v[3] * rstd_of(g.ssq_in, tok + 192, 1.f / 1024));
        EPI_END
      } else {
        u16* z = (u16*)g.d1;
        EPI_STD_BEGIN
          const float rs = rstd_of(g.ssq_in, m, 1.f / 1024);
          *(u32x2*)(z + (long)m * 1024 + (n4 - 2048)) = pack4(v[0] * rs, v[1] * rs, v[2] * rs, v[3] * rs);
        EPI_END
      }
    } else if (MODE == M_FFT1) {
      if (wy == 0) {
        u16* Zs = (u16*)g.d0; const float* tw = (const float*)g.d1;
        const int bt = mt >> 8, c = (mt & 255) * 4 + wx;
#pragma unroll
        for (int jj = 0; jj < 4; ++jj)
#pragma unroll
          for (int i = 0; i < 4; ++i) {
            const int a4 = i * 16 + lg * 4, v = jj * 16 + lq;
            const float4 t0 = *(const float4*)(tw + (v * 64 + a4) * 2), t1 = *(const float4*)(tw + (v * 64 + a4) * 2 + 4);
            const f32x4 zr = acc[i][jj], zi = acc[i][jj + 4];
            const long base = ((((long)(bt * 64 + v)) * 1024 + c) * 2) * 64 + a4;
            *(u32x2*)(Zs + base) = pack4(zr[0] * t0.x - zi[0] * t0.y, zr[1] * t0.z - zi[1] * t0.w,
                                         zr[2] * t1.x - zi[2] * t1.y, zr[3] * t1.z - zi[3] * t1.w);
            *(u32x2*)(Zs + base + 64) = pack4(zr[0] * t0.y + zi[0] * t0.x, zr[1] * t0.w + zi[1] * t0.z,
                                              zr[2] * t1.y + zi[2] * t1.x, zr[3] * t1.w + zi[3] * t1.z);
            __builtin_amdgcn_sched_barrier(0);
          }
      }
    } else if (MODE == M_FFT3) {
      if (wy == 0) {
        u16* og = (u16*)g.d0; const u16* z = (const u16*)g.d1;
        const int bt = mt >> 8, v = (mt >> 2) & 63, cq = mt & 3;
#pragma unroll
        for (int j = 0; j < 4; ++j)
#pragma unroll
          for (int i = 0; i < 4; ++i) {
            const int c4 = cq * 256 + wx * 64 + i * 16 + lg * 4, u = j * 16 + lq;
            const long o = ((long)bt * 4096 + 64 * u + v) * 1024 + c4;
            const f32x4 val = acc[i][j];
            const u32x2 zz = *(const u32x2*)(z + o);
            *(u32x2*)(og + o) = pack4(val[0] * silu(bflo(zz.x)), val[1] * silu(bfhi(zz.x)), val[2] * silu(bflo(zz.y)), val[3] * silu(bfhi(zz.y)));
            if (i == 3) __builtin_amdgcn_sched_barrier(0);
          }
      }
    } else if (MODE == M_SEQ) {
      u16* og = (u16*)g.d0; const u16* z = (const u16*)g.d1;
      EPI_STD_BEGIN
        const long o = ((long)bsel * 4096 + m) * 1024 + n4;
        const u32x2 zz = *(const u32x2*)(z + o);
        *(u32x2*)(og + o) = pack4(v[0] * silu(bflo(zz.x)), v[1] * silu(bfhi(zz.x)), v[2] * silu(bflo(zz.y)), v[3] * silu(bfhi(zz.y)));
      EPI_END
    } else if (MODE == M_OUT) {
      u16* xb = (u16*)g.d0;
      const float* xin = g.li ? p.out : (m0 < TP ? p.x_prompt : p.x_sample - (long)TP * 1024);
      EPI_STD_BEGIN
        float4* xp = (float4*)(p.out + (long)m * 1024 + n4);
        float4 xv = *(const float4*)(xin + (long)m * 1024 + n4);
        xv.x += v[0]; xv.y += v[1]; xv.z += v[2]; xv.w += v[3];
        *xp = xv;
        *(u32x2*)(xb + (long)m * 1024 + n4) = pack4(xv.x, xv.y, xv.z, xv.w);
      EPI_END
    } else if (MODE == M_PLE) {
      u16* xb = (u16*)g.d0;
      asm volatile("" : "+s"(xb));
#pragma unroll
      for (int j = 0; j < 8; ++j) {
        const int m = m0 + wy * 128 + j * 16 + lq;
        float sq = 0.f;
#pragma unroll
        for (int i = 0; i < 4; ++i) {
          const int n4 = n0 + wx * 64 + i * 16 + lg * 4;
          const f32x4 v = acc[i][j];
          const u32x2 pv = *(const u32x2*)(xb + (long)m * 1024 + n4);
          float4* xp = (float4*)(p.out + (long)m * 1024 + n4);
          float4 xv = *xp;
          xv.x += sigm(v[0]) * bflo(pv.x); xv.y += sigm(v[1]) * bfhi(pv.x); xv.z += sigm(v[2]) * bflo(pv.y); xv.w += sigm(v[3]) * bfhi(pv.y);
          *xp = xv;
          if (g.li != 3) *(u32x2*)(xb + (long)m * 1024 + n4) = pack4(xv.x, xv.y, xv.z, xv.w);
          sq += xv.x * xv.x + xv.y * xv.y + xv.z * xv.z + xv.w * xv.w;
        }
        sq += __shfl_xor(sq, 16);
        sq += __shfl_xor(sq, 32);
        if (lg == 0) atomicAdd(g.ssq_out + m, sq);
        __builtin_amdgcn_sched_barrier(0);
      }
    } else if (MODE == M_NA_IN) {
      if (transposed) {
        u16* Vt = (u16*)g.d2;
        EPI_TR_BEGIN
          const int b = m4 >> 12, s = m4 & 4095;
          *(u32x2*)(Vt + ((long)b * 1024 + (n - 2048)) * 4096 + s) =
              pack4(v[0] * rstd_of(g.ssq_in, m4, 1.f / 1024), v[1] * rstd_of(g.ssq_in, m4 + 1, 1.f / 1024),
                    v[2] * rstd_of(g.ssq_in, m4 + 2, 1.f / 1024), v[3] * rstd_of(g.ssq_in, m4 + 3, 1.f / 1024));
        EPI_END
      } else {
        u16* dst = (u16*)((unsigned char*)g.d0 + (nt < 4 ? 0L : (nt < 8 ? SL : 3 * SL)));
        const int nb = nt < 4 ? 0 : (nt < 8 ? 1024 : 3072);
        EPI_STD_BEGIN
          const float rs = rstd_of(g.ssq_in, m, 1.f / 1024);
          *(u32x2*)(dst + (long)m * 1024 + (n4 - nb)) = pack4(v[0] * rs, v[1] * rs, v[2] * rs, v[3] * rs);
        EPI_END
      }
    } else if (MODE == M_MLA_IN) {
      const int u = (n0 >> 6) + wx;
      if (u < 10) {
        u16* dst = (u16*)g.d0 + (u < 6 ? 0L : (long)T_TOK * 384);
        const int ldd = u < 6 ? 384 : 256, nb = u < 6 ? 0 : 384;
        float* sqo = g.ssq_out + (u < 6 ? 0 : T_TOK);
#pragma unroll
        for (int j = 0; j < 8; ++j) {
          const int m = m0 + wy * 128 + j * 16 + lq;
          const float rs = rstd_of(g.ssq_in, m, 1.f / 1024);
          float sq = 0.f;
#pragma unroll
          for (int i = 0; i < 4; ++i) {
            const int n4 = n0 + wx * 64 + i * 16 + lg * 4;
            const f32x4 v = acc[i][j] * rs;
            *(u32x2*)(dst + (long)m * ldd + (n4 - nb)) = pack4(v[0], v[1], v[2], v[3]);
            sq += v[0] * v[0] + v[1] * v[1] + v[2] * v[2] + v[3] * v[3];
          }
          sq += __shfl_xor(sq, 16);
          sq += __shfl_xor(sq, 32);
          if (lg == 0) atomicAdd(sqo + m, sq);
        }
      } else if (u == 10) {
        u16* kpe = (u16*)g.d2;
#pragma unroll
        for (int j = 0; j < 8; ++j)
#pragma unroll
          for (int i = 0; i < 2; ++i) {
            const int m = m0 + wy * 128 + j * 16 + lq, pos = m & 4095;
            const float rs = rstd_of(g.ssq_in, m, 1.f / 1024);
            const int f0 = i * 16 + lg * 4;
            const f32x4 a = acc[i][j], bq = acc[i + 2][j];
            float lo[4], hi[4];
#pragma unroll
            for (int r = 0; r < 4; ++r) {
              const float2 cssn = *(const float2*)(p.rope + ((long)pos * 32 + f0 + r) * 2);
              const float x1 = a[r] * rs, x2 = bq[r] * rs;
              lo[r] = x1 * cssn.x - x2 * cssn.y;
              hi[r] = x1 * cssn.y + x2 * cssn.x;
            }
            *(u32x2*)(kpe + (long)m * 64 + f0) = pack4(lo[0], lo[1], lo[2], lo[3]);
            *(u32x2*)(kpe + (long)m * 64 + 32 + f0) = pack4(hi[0], hi[1], hi[2], hi[3]);
          }
      }
    } else if (MODE == M_MLA_UQ) {
      u16* qo = (u16*)g.d0;
      const int slab = (n0 >> 6) + wx;
      if (slab % 3 == 2) {
#pragma unroll
        for (int j = 0; j < 8; ++j)
#pragma unroll
          for (int i = 0; i < 2; ++i) {
            const int m = m0 + wy * 128 + j * 16 + lq, pos = m & 4095;
            const float rs = rstd_of(g.ssq_in, m, 1.f / 384);
            const int f0 = i * 16 + lg * 4;
            const f32x4 a = acc[i][j], bq = acc[i + 2][j];
            float lo[4], hi[4];
#pragma unroll
            for (int r = 0; r < 4; ++r) {
              const float2 cssn = *(const float2*)(p.rope + ((long)pos * 32 + f0 + r) * 2);
              const float x1 = a[r] * rs, x2 = bq[r] * rs;
              lo[r] = x1 * cssn.x - x2 * cssn.y;
              hi[r] = x1 * cssn.y + x2 * cssn.x;
            }
            *(u32x2*)(qo + (long)m * 1536 + slab * 64 + f0) = pack4(lo[0], lo[1], lo[2], lo[3]);
            *(u32x2*)(qo + (long)m * 1536 + slab * 64 + 32 + f0) = pack4(hi[0], hi[1], hi[2], hi[3]);
          }
      } else {
        EPI_STD_BEGIN
          const float rs = rstd_of(g.ssq_in, m, 1.f / 384);
          *(u32x2*)(qo + (long)m * 1536 + n4) = pack4(v[0] * rs, v[1] * rs, v[2] * rs, v[3] * rs);
        EPI_END
      }
    } else if (MODE == M_MLA_UKV) {
      if (transposed) {
        u16* Vt = (u16*)g.d1;
        EPI_TR_BEGIN
          const int b = m4 >> 12, s = m4 & 4095;
          *(u32x2*)(Vt + ((long)b * 1024 + (n - 1024)) * 4096 + s) =
              pack4(v[0] * rstd_of(g.ssq_in, m4, 1.f / 256), v[1] * rstd_of(g.ssq_in, m4 + 1, 1.f / 256),
                    v[2] * rstd_of(g.ssq_in, m4 + 2, 1.f / 256), v[3] * rstd_of(g.ssq_in, m4 + 3, 1.f / 256));
        EPI_END
      } else {
        u16* kn = (u16*)g.d0;
        EPI_STD_BEGIN
          const float rs = rstd_of(g.ssq_in, m, 1.f / 256);
          *(u32x2*)(kn + (long)m * 1024 + n4) = pack4(v[0] * rs, v[1] * rs, v[2] * rs, v[3] * rs);
        EPI_END
      }
    } else if (MODE == M_ZPASS) {
      u16* og = (u16*)g.d0;
      EPI_STD_BEGIN
        const float rs = rstd_of(g.ssq_in, m, 1.f / 1024);
        u32x2* op = (u32x2*)(og + (long)m * 1024 + n4);
        const u32x2 ov = *op;
        *op = pack4(bflo(ov.x) * silu(v[0] * rs), bfhi(ov.x) * silu(v[1] * rs), bflo(ov.y) * silu(v[2] * rs), bfhi(ov.y) * silu(v[3] * rs));
      EPI_END
    } else if (MODE == M_HG_IN) {
      if (transposed) {
        u16* iT = (u16*)g.d3;
        EPI_TR_BEGIN
          const int b = m4 >> 12, s = m4 & 4095;
          *(u32x2*)(iT + ((long)b * 1024 + (n - 3072)) * 4096 + s) =
              pack4(v[0] * rstd_of(g.ssq_in, m4, 1.f / 1024), v[1] * rstd_of(g.ssq_in, m4 + 1, 1.f / 1024),
                    v[2] * rstd_of(g.ssq_in, m4 + 2, 1.f / 1024), v[3] * rstd_of(g.ssq_in, m4 + 3, 1.f / 1024));
        EPI_END
      } else if (nt < 4) {
        u16* qo = (u16*)g.d0;
        EPI_STD_BEGIN
          const float rs = rstd_of(g.ssq_in, m, 1.f / 1024);
          *(u32x2*)(qo + (long)m * 1024 + n4) = pack4(silu(v[0] * rs), silu(v[1] * rs), silu(v[2] * rs), silu(v[3] * rs));
        EPI_END
      } else {
        const int dir = nt >= 8;
        __half* go = (__half*)((unsigned char*)g.d1 + (dir ? SL : 0L));
        EPI_STD_BEGIN
          const float rs = rstd_of(g.ssq_in, m, 1.f / 1024);
          const int c = n4 - 1024 - dir * 1024;
          const float4 lbv = *(const float4*)(p.lb + dir * 1024 + c);
          __half2 h01, h23;
          h01.x = __float2half(__logf(lbv.x + (1.f - lbv.x) * sigm(v[0] * rs)));
          h01.y = __float2half(__logf(lbv.y + (1.f - lbv.y) * sigm(v[1] * rs)));
          h23.x = __float2half(__logf(lbv.z + (1.f - lbv.z) * sigm(v[2] * rs)));
          h23.y = __float2half(__logf(lbv.w + (1.f - lbv.w) * sigm(v[3] * rs)));
          __half2* dp = (__half2*)(go + (long)m * 1024 + c);
          dp[0] = h01; dp[1] = h23;
        EPI_END
      }
    }
  }
}

DI void convert_p(const Params& p, int li, u16* dst) {
  const long gt = (long)blockIdx.x * NTHR + tid_opaque(), gn = (long)gridDim.x * NTHR;
  for (long id = gt; id < (long)T_TOK * 64; id += gn) {
    const long m = id >> 6; const int c4 = (int)(id & 63) * 4;
    const float* src = (m < TP) ? p.p_prompt + ((long)li * TP + m) * 256 : p.p_sample + ((long)li * (T_TOK - TP) + (m - TP)) * 256;
    const float4 v = *(const float4*)(src + c4);
    *(u32x2*)(dst + m * 256 + c4) = pack4(v.x, v.y, v.z, v.w);
  }
}

DI void na_phase(const Params& p, const u16* q, const u16* k, const u16* vt, const u16* z, u16* og, unsigned char* smem) {
  if (!((PH_MASK >> 10) & 1u)) return;
  const int t = tid_opaque(), l = t & 63, w = __builtin_amdgcn_readfirstlane(t >> 6), lq = l & 15, lg = l >> 4;
  const int hh = w >> 1, jb = (w & 1) * 2;
  float* rp = (float*)(smem + 131072) + hh * 480;
  constexpr int NSTG = 32768;
  int cur_hg = -1;
  for (int item = blockIdx.x; item < 20 * 64 * 8; item += gridDim.x) {
    const int hg = item & 7, r = (item >> 3) & 63, b = item >> 9;
    const int h = hg * 4 + hh;
    const int rs = min(max(r - 4, 0), 56);
    __syncthreads();
    if (hg != cur_hg) {
      if (!(w & 1)) for (int i = l; i < 465; i += 64) rp[i] = p.na_rpb[h * 465 + i];
      cur_hg = hg;
    }
    auto issue = [&](int ri) {
      const int t2 = tid_opaque();
      unsigned char* sb = smem + (ri & 3) * NSTG + t2 * 16;
      const long tok0 = (long)b * 4096 + (rs + ri) * 64;
#pragma unroll
      for (int i = 0; i < 2; ++i) {
        const int cid = t2 + 512 * i, row = cid >> 4, c = (cid & 15) ^ (row & 15);
        __builtin_amdgcn_global_load_lds((const unsigned*)(k + (tok0 + row) * 1024 + hg * 128 + c * 8), LDS_PTR(sb + i * 8192), 16, 0, 0);
      }
#pragma unroll
      for (int i = 0; i < 2; ++i) {
        const int cid = t2 + 512 * i, row = cid >> 3, c = (cid & 7) ^ ((row >> 1) & 7);
        __builtin_amdgcn_global_load_lds((const unsigned*)(vt + ((long)(b * 1024 + hg * 128 + row)) * 4096 + (rs + ri) * 64 + c * 8),
                                         LDS_PTR(sb + 16384 + i * 8192), 16, 0, 0);
      }
    };
    bf16x8 qf[2];
#pragma unroll
    for (int jj = 0; jj < 2; ++jj)
      qf[jj] = *(const bf16x8*)(q + ((long)b * 4096 + r * 64 + (jb + jj) * 16 + lq) * 1024 + h * 32 + lg * 8);
    issue(0); issue(1); issue(2);
    f32x4 o[2][2];
    float lrun[2];
#pragma unroll
    for (int jj = 0; jj < 2; ++jj) { o[jj][0] = f32x4{0.f, 0.f, 0.f, 0.f}; o[jj][1] = f32x4{0.f, 0.f, 0.f, 0.f}; lrun[jj] = 0.f; }
#pragma unroll 1
    for (int ri = 0; ri < 8; ++ri) {
      if (ri <= 5) asm volatile("s_waitcnt vmcnt(8)" ::: "memory");
      else if (ri == 6) asm volatile("s_waitcnt vmcnt(4)" ::: "memory");
      else asm volatile("s_waitcnt vmcnt(0)" ::: "memory");
      asm volatile("s_waitcnt lgkmcnt(0)" ::: "memory");
      __builtin_amdgcn_s_barrier();
      if (ri + 3 < 8) issue(ri + 3);
      const unsigned char* Ks = smem + (ri & 3) * NSTG;
      const unsigned char* Vs = Ks + 16384;
      const int ro = rs + ri - r + 7;
#pragma unroll
      for (int jj = 0; jj < 2; ++jj) {
        const int j = jb + jj;
        const int kcs = min(max(j * 16 - 8, 0), 32);
        f32x4 sc[2];
#pragma unroll
        for (int c2 = 0; c2 < 2; ++c2) {
          const int row = kcs + c2 * 16 + lq;
          const bf16x8 kf = *(const bf16x8*)(Ks + row * 256 + (((hh * 4 + lg) ^ (row & 15)) << 4));
          sc[c2] = MFMA16(kf, qf[jj], (f32x4{0.f, 0.f, 0.f, 0.f}));
        }
        const int qcol = j * 16 + lq, win = min(max(qcol - 8, 0), 48);
        float ps = 0.f;
#pragma unroll
        for (int c2 = 0; c2 < 2; ++c2)
#pragma unroll
          for (int rr = 0; rr < 4; ++rr) {
            const int kcol = kcs + c2 * 16 + lg * 4 + rr;
            const bool valid = (kcol >= win) && (kcol < win + 16);
            const int co = min(max(kcol - qcol + 15, 0), 30);
            const float e = valid ? __expf(fminf(sc[c2][rr] + rp[ro * 31 + co], 80.f)) : 0.f;
            sc[c2][rr] = e;
            ps += e;
          }
        lrun[jj] += ps;
        const bf16x8 pf = pack8(sc[0], sc[1]);
#pragma unroll
        for (int dt = 0; dt < 2; ++dt) {
          const int vrow = hh * 32 + dt * 16 + lq, vsw = (vrow >> 1) & 7, ch = (kcs >> 3) + (lg >> 1);
          const unsigned char* vr = Vs + vrow * 128 + (lg & 1) * 8;
          const s16x4 lo = *(const s16x4*)(vr + ((ch ^ vsw) << 4));
          const s16x4 hi = *(const s16x4*)(vr + (((ch + 2) ^ vsw) << 4));
          o[jj][dt] = MFMA16(cat8(lo, hi), pf, o[jj][dt]);
        }
      }
    }
#pragma unroll
    for (int jj = 0; jj < 2; ++jj) {
      float ls = lrun[jj];
      ls += __shfl_xor(ls, 16);
      ls += __shfl_xor(ls, 32);
      const float inv = __builtin_amdgcn_rcpf(ls);
#pragma unroll
      for (int dt = 0; dt < 2; ++dt) {
        const long off = ((long)b * 4096 + r * 64 + (jb + jj) * 16 + lq) * 1024 + h * 32 + dt * 16 + lg * 4;
        const u32x2 zz = *(const u32x2*)(z + off);
        *(u32x2*)(og + off) = pack4(o[jj][dt][0] * inv * silu(bflo(zz.x)), o[jj][dt][1] * inv * silu(bfhi(zz.x)),
                                    o[jj][dt][2] * inv * silu(bflo(zz.y)), o[jj][dt][3] * inv * silu(bfhi(zz.y)));
      }
    }
  }
  __syncthreads();
}

DI void mla_attn(const u16* q, const u16* kn, const u16* kpe, const u16* vt, u16* o, unsigned char* smem) {
  if (!((PH_MASK >> 11) & 1u)) return;
  const int t = tid_opaque(), l = t & 63, w = __builtin_amdgcn_readfirstlane(t >> 6), lq = l & 15, lg = l >> 4;
  const int fsw = (lq >> 1) & 7;
  constexpr int NQT = 2, QPB = 128 * NQT, NQB = 4096 / QPB, MSTAGE = 40960;
  for (int item = blockIdx.x; item < 20 * 8 * NQB; item += gridDim.x) {
    const int qb = item % NQB, h = (item / NQB) & 7, b = item / (NQB * 8);
    const long tb = (long)b * 4096;
    bf16x8 qf[NQT][6];
#pragma unroll
    for (int qt = 0; qt < NQT; ++qt)
#pragma unroll
      for (int ks = 0; ks < 6; ++ks)
        qf[qt][ks] = *(const bf16x8*)(q + (tb + qb * QPB + w * 16 * NQT + qt * 16 + lq) * 1536 + h * 192 + ks * 32 + lg * 8);
    f32x4 oacc[8][NQT];
#pragma unroll
    for (int dt = 0; dt < 8; ++dt)
#pragma unroll
      for (int qt = 0; qt < NQT; ++qt) oacc[dt][qt] = f32x4{0.f, 0.f, 0.f, 0.f};
    float mrun[NQT], lrun[NQT];
#pragma unroll
    for (int qt = 0; qt < NQT; ++qt) { mrun[qt] = -1e30f; lrun[qt] = 0.f; }
    auto issue = [&](int kt, int stage) {
      const int t2 = tid_opaque();
      unsigned char* sb = smem + stage * MSTAGE + t2 * 16;
      const long k0 = tb + kt * 64;
#pragma unroll
      for (int i = 0; i < 3; ++i) {
        const int cid = t2 + 512 * i, row = cid / 24, c = (cid - row * 24) ^ ((row >> 1) & 7);
        const u16* src = c < 16 ? kn + (k0 + row) * 1024 + h * 128 + c * 8 : kpe + (k0 + row) * 64 + (c - 16) * 8;
        __builtin_amdgcn_global_load_lds((const unsigned*)src, LDS_PTR(sb + i * 8192), 16, 0, 0);
      }
#pragma unroll
      for (int i = 0; i < 2; ++i) {
        const int cid = t2 + 512 * i, d = cid >> 3, c = (cid & 7) ^ ((d >> 1) & 7);
        __builtin_amdgcn_global_load_lds((const unsigned*)(vt + ((long)(b * 1024 + h * 128 + d)) * 4096 + kt * 64 + c * 8),
                                         LDS_PTR(sb + 24576 + i * 8192), 16, 0, 0);
      }
    };
    __syncthreads();
    issue(0, 0);
    issue(1, 1);
    int st = 0;
#pragma unroll 1
    for (int kt = 0; kt < 64; ++kt) {
      if (kt + 1 < 64) asm volatile("s_waitcnt vmcnt(5)" ::: "memory");
      else asm volatile("s_waitcnt vmcnt(0)" ::: "memory");
      __builtin_amdgcn_s_barrier();
      if (kt + 2 < 64) { int s2 = st + 2; if (s2 >= 3) s2 -= 3; issue(kt + 2, s2); }
      const unsigned char* Kt = smem + st * MSTAGE;
      const unsigned char* Vt = Kt + 24576;
      f32x4 s[4][NQT];
#pragma unroll
      for (int k16 = 0; k16 < 4; ++k16)
#pragma unroll
        for (int qt = 0; qt < NQT; ++qt) s[k16][qt] = f32x4{0.f, 0.f, 0.f, 0.f};
#pragma unroll
      for (int ks = 0; ks < 6; ++ks) {
#pragma unroll
        for (int k16 = 0; k16 < 4; ++k16) {
          const bf16x8 kf = *(const bf16x8*)(Kt + (k16 * 16 + lq) * 384 + (((ks * 4 + lg) ^ fsw) << 4));
#pragma unroll
          for (int qt = 0; qt < NQT; ++qt) s[k16][qt] = MFMA16(kf, qf[qt][ks], s[k16][qt]);
        }
        if (ks & 1) __builtin_amdgcn_sched_barrier(0);
      }
      bf16x8 pf[NQT][2];
#pragma unroll
      for (int qt = 0; qt < NQT; ++qt) {
        float ps = 0.f;
#pragma unroll
        for (int k16 = 0; k16 < 4; ++k16)
#pragma unroll
          for (int rr = 0; rr < 4; ++rr) { const float e = __builtin_amdgcn_exp2f(fminf(s[k16][qt][rr], 100.f)); s[k16][qt][rr] = e; ps += e; }
        lrun[qt] += ps;
        pf[qt][0] = pack8(s[0][qt], s[1][qt]);
        pf[qt][1] = pack8(s[2][qt], s[3][qt]);
      }
#pragma unroll
      for (int kk = 0; kk < 2; ++kk)
#pragma unroll
        for (int dt = 0; dt < 8; ++dt) {
          const unsigned char* vr = Vt + (dt * 16 + lq) * 128 + (lg & 1) * 8;
          const s16x4 lo = *(const s16x4*)(vr + (((kk * 4 + (lg >> 1)) ^ fsw) << 4));
          const s16x4 hi = *(const s16x4*)(vr + (((kk * 4 + (lg >> 1) + 2) ^ fsw) << 4));
          const bf16x8 vf = cat8(lo, hi);
#pragma unroll
          for (int qt = 0; qt < NQT; ++qt) oacc[dt][qt] = MFMA16(vf, pf[qt][kk], oacc[dt][qt]);
        }
      st = (st == 2) ? 0 : st + 1;
    }
#pragma unroll
    for (int qt = 0; qt < NQT; ++qt) {
      float ls = lrun[qt];
      ls += __shfl_xor(ls, 16);
      ls += __shfl_xor(ls, 32);
      const float inv = __builtin_amdgcn_rcpf(ls);
      const long row = (tb + qb * QPB + w * 16 * NQT + qt * 16 + lq) * 1024 + h * 128 + lg * 4;
#pragma unroll
      for (int dt = 0; dt < 8; ++dt)
        *(u32x2*)(o + row + dt * 16) = pack4(oacc[dt][qt][0] * inv, oacc[dt][qt][1] * inv, oacc[dt][qt][2] * inv, oacc[dt][qt][3] * inv);
    }
  }
}

DI u32x4 rev8(u32x4 v) {
  u32x4 r;
  r.x = (v.w >> 16) | (v.w << 16); r.y = (v.z >> 16) | (v.z << 16); r.z = (v.y >> 16) | (v.y << 16); r.w = (v.x >> 16) | (v.x << 16);
  return r;
}
DI void hg_scan(const u16* qh, const __half* gf, const __half* gb, const u16* it, const float* g_out, u16* o, unsigned char* smem) {
  if (!((PH_MASK >> 12) & 1u)) return;
  const int t = tid_opaque(), l = t & 63, w = __builtin_amdgcn_readfirstlane(t >> 6), lq = l & 15, lg = l >> 4;
  unsigned char* QT = smem;
  unsigned char* KT = smem + 16384;
  unsigned char* KH = smem + 32768;
  unsigned char* VT = smem + 49152;
  u16* RQ = (u16*)(smem + 65536);
  __half* RG = (__half*)(smem + 81920);
  float* RED = (float*)(smem + 98304);
  float* DEC = (float*)(smem + 98304 + 2048);
  float* PS = (float*)(smem + 98304 + 2048 + 512);
  const int vs = w * 16, vsw = (lq >> 1) & 7;
  const int col = t & 127, qr = t >> 7;
  for (int item = blockIdx.x; item < 160; item += gridDim.x) {
    const int b = item >> 3, h = item & 7;
    for (int dir = 0; dir < 2; ++dir) {
      const __half* gsrc = dir ? gb : gf;
      f32x4 S[8];
#pragma unroll
      for (int ct = 0; ct < 8; ++ct) S[ct] = f32x4{0.f, 0.f, 0.f, 0.f};
      u32x4 rq[2], rgv[2], rv[2];
      auto gload = [&](int step) {
        const int cidx = dir ? 63 - step : step;
        const long tok0 = (long)b * 4096 + cidx * 64;
#pragma unroll
        for (int i = 0; i < 2; ++i) {
          const int cid = t + 512 * i, row = cid >> 4, c = cid & 15;
          rq[i] = *(const u32x4*)(qh + (tok0 + row) * 1024 + h * 128 + c * 8);
          rgv[i] = *(const u32x4*)(gsrc + (tok0 + row) * 1024 + h * 128 + c * 8);
          const int vv = cid >> 3, c8 = cid & 7;
          rv[i] = *(const u32x4*)(it + ((long)(b * 1024 + h * 128 + vv)) * 4096 + cidx * 64 + c8 * 8);
        }
      };
      auto store_raw = [&]() {
#pragma unroll
        for (int i = 0; i < 2; ++i) {
          const int cid = t + 512 * i, row = cid >> 4, c = cid & 15;
          const int rw = dir ? 63 - row : row;
          *(u32x4*)((unsigned char*)RQ + rw * 256 + c * 16) = rq[i];
          *(u32x4*)((unsigned char*)RG + rw * 256 + c * 16) = rgv[i];
        }
      };
      auto store_v = [&]() {
#pragma unroll
        for (int i = 0; i < 2; ++i) {
          const int cid = t + 512 * i, vv = cid >> 3, c8 = cid & 7;
          const int cc = dir ? 7 - c8 : c8;
          *(u32x4*)(VT + vv * 128 + ((cc ^ ((vv >> 1) & 7)) << 4)) = dir ? rev8(rv[i]) : rv[i];
        }
      };
      __syncthreads();
      gload(0);
      store_raw();
      store_v();
      __syncthreads();
      for (int step = 0; step < 64; ++step) {
        const int cidx = dir ? 63 - step : step;
        const long tok0 = (long)b * 4096 + cidx * 64;
        if (step + 1 < 64) gload(step + 1);
        {
          float gvr[16];
          float psum = 0.f;
#pragma unroll
          for (int rr = 0; rr < 16; ++rr) { gvr[rr] = __half2float(RG[(qr * 16 + rr) * 128 + col]); psum += gvr[rr]; }
          PS[qr * 128 + col] = psum;
          __syncthreads();
          const float p0 = PS[col], p1 = PS[128 + col], p2 = PS[256 + col], p3 = PS[384 + col];
          const float tot = (p0 + p1) + (p2 + p3);
          const float pre = (qr > 0 ? p0 : 0.f) + (qr > 1 ? p1 : 0.f) + (qr > 2 ? p2 : 0.f);
          float eb = __expf(pre), ieb = __expf(-pre);
          const float etot = __expf(tot);
          unsigned khp[8];
#pragma unroll
          for (int rr = 0; rr < 16; ++rr) {
            const int r = qr * 16 + rr;
            const float f = __expf(gvr[rr]);
            eb *= f;
            ieb *= __builtin_amdgcn_rcpf(f);
            const float qv = bf2f(RQ[r * 128 + col]);
            const float kk = 1.f - f;
            const float kt = kk * ieb;
            const unsigned off = r * 256 + (((col >> 3) ^ (r & 15)) << 4) + (col & 7) * 2;
            *(u16*)(QT + off) = f2bf(qv * eb);
            *(u16*)(KT + off) = f2bf(kt);
            const float kh = kt * etot;
            if (rr & 1) khp[rr >> 1] = pack2(__uint_as_float(khp[rr >> 1]), kh); else khp[rr >> 1] = __float_as_uint(kh);
          }
          const int sw = (col >> 1) & 7;
          u32x4 k0, k1;
          k0.x = khp[0]; k0.y = khp[1]; k0.z = khp[2]; k0.w = khp[3];
          k1.x = khp[4]; k1.y = khp[5]; k1.z = khp[6]; k1.w = khp[7];
          *(u32x4*)(KH + col * 128 + (((qr * 2) ^ sw) << 4)) = k0;
          *(u32x4*)(KH + col * 128 + (((qr * 2 + 1) ^ sw) << 4)) = k1;
          if (qr == 0) DEC[col] = etot;
        }
        __syncthreads();
        if (step + 1 < 64) store_raw();
        __builtin_amdgcn_sched_barrier(0);
        bf16x8 Sop[4];
#pragma unroll
        for (int i = 0; i < 4; ++i) Sop[i] = pack8(S[2 * i], S[2 * i + 1]);
        f32x4 ot[4];
#pragma unroll
        for (int tt = 0; tt < 4; ++tt) {
          const unsigned char* qrow = QT + (tt * 16 + lq) * 256;
          bf16x8 qB[4];
#pragma unroll
          for (int ks = 0; ks < 4; ++ks) qB[ks] = *(const bf16x8*)(qrow + (((ks * 4 + lg) ^ lq) << 4));
          f32x4 at[4];
#pragma unroll
          for (int st = 0; st < 4; ++st) {
            at[st] = f32x4{0.f, 0.f, 0.f, 0.f};
            if (st <= tt) {
              const unsigned char* krow = KT + (st * 16 + lq) * 256;
#pragma unroll
              for (int ks = 0; ks < 4; ++ks) {
                const bf16x8 kA = *(const bf16x8*)(krow + (((ks * 4 + lg) ^ lq) << 4));
                at[st] = MFMA16(kA, qB[ks], at[st]);
              }
              if (st == tt) {
#pragma unroll
                for (int rr = 0; rr < 4; ++rr) if (lg * 4 + rr > lq) at[st][rr] = 0.f;
              }
            }
          }
          f32x4 acc = f32x4{0.f, 0.f, 0.f, 0.f};
#pragma unroll
          for (int kk = 0; kk < 2; ++kk) {
            if (2 * kk <= tt) {
              const bf16x8 pfr = pack8(at[2 * kk], at[2 * kk + 1]);
              const unsigned char* vr = VT + (vs + lq) * 128 + (lg & 1) * 8;
              const s16x4 lo = *(const s16x4*)(vr + (((kk * 4 + (lg >> 1)) ^ vsw) << 4));
              const s16x4 hi = *(const s16x4*)(vr + (((kk * 4 + (lg >> 1) + 2) ^ vsw) << 4));
              acc = MFMA16(cat8(lo, hi), pfr, acc);
            }
          }
#pragma unroll
          for (int i = 0; i < 4; ++i) {
            const unsigned char* qr8 = qrow + (lg & 1) * 8;
            const s16x4 lo = *(const s16x4*)(qr8 + (((i * 4 + (lg >> 1)) ^ lq) << 4));
            const s16x4 hi = *(const s16x4*)(qr8 + (((i * 4 + (lg >> 1) + 2) ^ lq) << 4));
            acc = MFMA16(Sop[i], cat8(lo, hi), acc);
          }
          ot[tt] = acc;
          __builtin_amdgcn_sched_barrier(0);
        }
#pragma unroll
        for (int ct = 0; ct < 8; ++ct) {
          const f32x4 dc = *(const f32x4*)(DEC + ct * 16 + lg * 4);
          f32x4 sn = S[ct] * dc;
#pragma unroll
          for (int kk = 0; kk < 2; ++kk) {
            const bf16x8 khA = *(const bf16x8*)(KH + (ct * 16 + lq) * 128 + (((kk * 4 + lg) ^ vsw) << 4));
            const bf16x8 vB = *(const bf16x8*)(VT + (vs + lq) * 128 + (((kk * 4 + lg) ^ vsw) << 4));
            sn = MFMA16(khA, vB, sn);
          }
          S[ct] = sn;
          if (ct & 1) __builtin_amdgcn_sched_barrier(0);
        }
        if (dir == 0) {
#pragma unroll
          for (int tt = 0; tt < 4; ++tt) {
            const long off = (tok0 + tt * 16 + lq) * 1024 + h * 128 + vs + lg * 4;
            *(u32x2*)(o + off) = pack4(ot[tt][0], ot[tt][1], ot[tt][2], ot[tt][3]);
          }
        } else {
#pragma unroll
          for (int tt = 0; tt < 4; ++tt) {
            const long off = (tok0 + 63 - (tt * 16 + lq)) * 1024 + h * 128 + vs + lg * 4;
            const u32x2 pv = *(const u32x2*)(o + off);
            ot[tt][0] += bflo(pv.x); ot[tt][1] += bfhi(pv.x); ot[tt][2] += bflo(pv.y); ot[tt][3] += bfhi(pv.y);
            float sq = ot[tt][0] * ot[tt][0] + ot[tt][1] * ot[tt][1] + ot[tt][2] * ot[tt][2] + ot[tt][3] * ot[tt][3];
            sq += __shfl_xor(sq, 16);
            sq += __shfl_xor(sq, 32);
            if (lg == 0) RED[w * 64 + tt * 16 + lq] = sq;
          }
          __syncthreads();
          const float4 gv = *(const float4*)(g_out + h * 128 + vs + lg * 4);
#pragma unroll
          for (int tt = 0; tt < 4; ++tt) {
            float sq = 0.f;
#pragma unroll
            for (int ww = 0; ww < 8; ++ww) sq += RED[ww * 64 + tt * 16 + lq];
            const float rs = rsqrtf(sq * (1.f / 128.f) + 1e-6f);
            const long off = (tok0 + 63 - (tt * 16 + lq)) * 1024 + h * 128 + vs + lg * 4;
            *(u32x2*)(o + off) = pack4(ot[tt][0] * rs * gv.x, ot[tt][1] * rs * gv.y, ot[tt][2] * rs * gv.z, ot[tt][3] * rs * gv.w);
          }
        }
        __syncthreads();
        if (step + 1 < 64) store_v();
      }
    }
  }
}

DI void final_norm(const Params& p) {
  const int tt_ = tid_opaque();
  const int l = tt_ & 63, gw = blockIdx.x * 8 + (tt_ >> 6), nw = gridDim.x * 8;
  for (int row = gw; row < T_TOK; row += nw) {
    float4* xp = (float4*)(p.out + (long)row * 1024);
    float4 v[4];
    float s = 0.f;
#pragma unroll
    for (int i = 0; i < 4; ++i) {
      v[i] = xp[l + 64 * i];
      s += v[i].x * v[i].x + v[i].y * v[i].y + v[i].z * v[i].z + v[i].w * v[i].w;
    }
#pragma unroll
    for (int o = 1; o < 64; o <<= 1) s += __shfl_xor(s, o);
    const float rs = rsqrtf(s * (1.f / 1024.f) + 1e-6f);
#pragma unroll
    for (int i = 0; i < 4; ++i) {
      const float4 g = ((const float4*)p.final_g)[l + 64 * i];
      v[i].x *= rs * g.x; v[i].y *= rs * g.y; v[i].z *= rs * g.z; v[i].w *= rs * g.w;
      xp[l + 64 * i] = v[i];
    }
  }
}

struct GSync { unsigned* bar; unsigned k; };
DI void gsync(GSync& gs) { cg::this_grid().sync(); }

DI void run_out_ple(const Params& p, GSync& gs, int li, u16* og, u16* x1b, u16* xb_out, const u16* Wout, unsigned char* smem) {
  GP g{};
  g.A = og; g.lda = 1024; g.W = Wout; g.K = 1024; g.ntn = 4; g.ntiles = 320 * 4; g.d0 = x1b; g.li = li;
  gemm_phase<M_OUT>(p, g, smem);
  convert_p(p, li, (u16*)p.proj);
  gsync(gs);
  GP g2{};
  g2.A = x1b; g2.lda = 1024; g2.W = p.Wg + (long)li * 1024 * 1024; g2.K = 1024; g2.ntn = 4; g2.ntiles = 320 * 4;
  g2.d0 = xb_out; g2.d1 = p.proj; g2.ssq_out = p.ssq + (long)(li + 1) * T_TOK; g2.W2 = p.Wp + (long)li * 1024 * 256; g2.li = li;
  gemm_phase<M_PLE>(p, g2, smem);
  gsync(gs);
}

__global__ void __launch_bounds__(NTHR) fwd_megakernel(Params p) {
  __shared__ __attribute__((aligned(16))) unsigned char smem[SMEM_BYTES];
  cg::grid_group grid = cg::this_grid();
  GSync gs{p.bar, 0u};
  if ((PH_MASK >> 13) & 1u) {
  prep_rows(p);
  prep_transposes(p, smem);
  prep_misc(p, smem);
  }
  grid.sync();
  if ((PH_MASK >> 13) & 1u) prep_wprime(p);
  gsync(gs);
  unsigned char* P = p.proj;
  {
    GP g{};
    g.A = p.buf0; g.lda = 1024; g.W = p.Wfn; g.K = 1024; g.ntn = 12; g.ntiles = 320 * 12;
    g.d0 = P; g.d1 = P + 2 * SL; g.ssq_in = p.ssq;
    gemm_phase<M_FN_IN>(p, g, smem);
    gsync(gs);
    GP f1{};
    f1.A = (const u16*)P; f1.W = (const u16*)(P + 3 * SL); f1.K = 128; f1.ntn = 1; f1.ntiles = 5120;
    f1.d0 = p.buf0; f1.d1 = (P + 3 * SL + 2 * 256 * 128 * 2);
    gemm_phase<M_FFT1>(p, f1, smem);
    gsync(gs);
    GP f3{};
    f3.A = p.buf0; f3.W = (const u16*)(P + 3 * SL) + 256 * 128; f3.K = 128; f3.ntn = 1; f3.ntiles = 5120;
    f3.d0 = P + SL; f3.d1 = P + 2 * SL;
    gemm_phase<M_FFT3>(p, f3, smem);
    gsync(gs);
    run_out_ple(p, gs, 0, (u16*)(P + SL), p.buf0, p.buf1, p.Wfn_out, smem);
  }
  {
    GP g{};
    g.A = p.buf1; g.lda = 1024; g.W = p.Wna; g.K = 1024; g.ntn = 16; g.ntiles = 320 * 16;
    g.d0 = P; g.d1 = P + SL; g.d2 = P + 2 * SL; g.d3 = P + 3 * SL; g.ssq_in = p.ssq + T_TOK;
    gemm_phase<M_NA_IN>(p, g, smem);
    gsync(gs);
    na_phase(p, (const u16*)P, (const u16*)(P + SL), (const u16*)(P + 2 * SL), (const u16*)(P + 3 * SL), p.buf0, smem);
    gsync(gs);
    run_out_ple(p, gs, 1, p.buf0, p.buf1, p.buf0, p.Wna_out, smem);
  }
  {
    u16* cq = p.buf1; u16* ckv = p.buf1 + (long)T_TOK * 384;
    u16* qo = (u16*)P; u16* kn = (u16*)(P + SL + SL / 2); u16* vt = (u16*)(P + 2 * SL + SL / 2); u16* kpe = (u16*)(P + 3 * SL + SL / 2);
    GP g{};
    g.A = p.buf0; g.lda = 1024; g.W = p.Wmla_in; g.K = 1024; g.ntn = 3; g.ntiles = 320 * 3;
    g.d0 = cq; g.d1 = ckv; g.d2 = kpe; g.ssq_in = p.ssq + 2L * T_TOK; g.ssq_out = p.ssq_q; g.ssq_out2 = p.ssq_kv;
    gemm_phase<M_MLA_IN>(p, g, smem);
    gsync(gs);
    GP u{};
    u.A = cq; u.lda = 384; u.W = p.Wuq; u.K = 384; u.ntn = 6; u.ntiles = 320 * 6; u.d0 = qo; u.ssq_in = p.ssq_q;
    gemm_phase<M_MLA_UQ>(p, u, smem);
    GP v{};
    v.A = ckv; v.lda = 256; v.W = p.Wukv; v.K = 256; v.ntn = 8; v.ntiles = 320 * 8; v.d0 = kn; v.d1 = vt; v.ssq_in = p.ssq_kv;
    gemm_phase<M_MLA_UKV>(p, v, smem);
    gsync(gs);
    mla_attn(qo, kn, kpe, vt, p.buf1, smem);
    gsync(gs);
    GP z{};
    z.A = p.buf0; z.lda = 1024; z.W = p.Wmla_z; z.K = 1024; z.ntn = 4; z.ntiles = 320 * 4; z.d0 = p.buf1; z.ssq_in = p.ssq + 2L * T_TOK;
    gemm_phase<M_ZPASS>(p, z, smem);
    gsync(gs);
    run_out_ple(p, gs, 2, p.buf1, p.buf0, p.buf1, p.Wmla_out, smem);
  }
  {
    GP g{};
    g.A = p.buf1; g.lda = 1024; g.W = p.Whg; g.K = 1024; g.ntn = 16; g.ntiles = 320 * 16;
    g.d0 = P; g.d1 = P + SL; g.d2 = P + 2 * SL; g.d3 = P + 3 * SL; g.ssq_in = p.ssq + 3L * T_TOK;
    gemm_phase<M_HG_IN>(p, g, smem);
    gsync(gs);
    hg_scan((const u16*)P, (const __half*)(P + SL), (const __half*)(P + 2 * SL), (const u16*)(P + 3 * SL), p.hg_g_out, p.buf0, smem);
    gsync(gs);
    GP z{};
    z.A = p.buf1; z.lda = 1024; z.W = p.Whg_z; z.K = 1024; z.ntn = 4; z.ntiles = 320 * 4; z.d0 = p.buf0; z.ssq_in = p.ssq + 3L * T_TOK;
    gemm_phase<M_ZPASS>(p, z, smem);
    gsync(gs);
    run_out_ple(p, gs, 3, p.buf0, p.buf1, p.buf0, p.Whg_out, smem);
  }
  final_norm(p);
}

extern "C" void kernel_launch(void* const* d_in, const int* in_sizes, int n_in, void* d_out, int out_size,
                              void* d_ws, size_t ws_size, hipStream_t stream) {
  static int grid_blocks = 0;
  if (!grid_blocks) {
    int dev = 0, cus = 0, per_cu = 0;
    hipGetDevice(&dev);
    hipDeviceGetAttribute(&cus, hipDeviceAttributeMultiprocessorCount, dev);
    hipOccupancyMaxActiveBlocksPerMultiprocessor(&per_cu, fwd_megakernel, NTHR, 0);
    if (per_cu < 1) per_cu = 1;
    if (per_cu > 1) per_cu = 1;
    grid_blocks = cus * per_cu;
  }
  Params p;
  memset(&p, 0, sizeof(p));
  const float* const* in = (const float* const*)d_in;
  p.x_prompt = in[0]; p.x_sample = in[1]; p.p_prompt = in[2]; p.p_sample = in[3]; p.norm_g = in[4];
  p.fn_w_in = in[5]; p.fn_w_mix = in[6]; p.na_rpb = in[9]; p.hg_lb_raw = in[18]; p.hg_g_out = in[19]; p.final_g = in[23];
  const float* fn_w_out = in[7]; const float* na_w_in = in[8]; const float* na_w_out = in[10];
  const float* mla_w_in = in[11]; const float* mla_g_q = in[12]; const float* mla_w_uq = in[13];
  const float* mla_g_kv = in[14]; const float* mla_w_ukv = in[15]; const float* mla_w_out = in[16];
  const float* hg_w_in = in[17]; const float* hg_w_out = in[20]; const float* ple_w = in[21]; const float* ple_gate_w = in[22];
  p.out = (float*)d_out;
  unsigned char* ws = (unsigned char*)d_ws;
  size_t off = 0;
  auto take = [&](size_t bytes) { unsigned char* r = ws + off; off += (bytes + 255) & ~(size_t)255; return r; };
  p.buf0 = (u16*)take(SL); p.buf1 = (u16*)take(SL); p.proj = take(4 * SL);
  p.Wfn = (u16*)take(3072L * 1024 * 2); p.Wfn_out = (u16*)take(1024L * 1024 * 2);
  p.Wna = (u16*)take(4096L * 1024 * 2); p.Wna_out = (u16*)take(1024L * 1024 * 2);
  p.Wmla_in = (u16*)take(768L * 1024 * 2); p.Wmla_z = (u16*)take(1024L * 1024 * 2);
  p.Wuq = (u16*)take(1536L * 384 * 2); p.Wukv = (u16*)take(2048L * 256 * 2); p.Wmla_out = (u16*)take(1024L * 1024 * 2);
  p.Whg = (u16*)take(4096L * 1024 * 2); p.Whg_z = (u16*)take(1024L * 1024 * 2); p.Whg_out = (u16*)take(1024L * 1024 * 2);
  p.Wp = (u16*)take(4L * 1024 * 256 * 2); p.Wg = (u16*)take(4L * 1024 * 1024 * 2);
  p.CW = (float*)take(8L * 128 * 256 * 4); p.rope = (float*)take(4096L * 32 * 2 * 4);
  p.ssq = (float*)take(5L * T_TOK * 4); p.ssq_q = (float*)take((long)T_TOK * 4); p.ssq_kv = (float*)take((long)T_TOK * 4);
  p.lb = (float*)take(2048 * 4);
  p.bar = (unsigned*)take(256);
  if (off > ws_size) { fprintf(stderr, "workspace too small: need %zu have %zu\n", off, ws_size); return; }
  int nj = 0, tiles = 0;
  auto job = [&](const float* src, const float* g, u16* dst, int ld, int col0, int K, int N, float scale) {
    TJob& j = p.jobs[nj++];
    j.src = src; j.g = g; j.dst = dst; j.ld = ld; j.col0 = col0; j.K = K; j.N = N; j.scale = scale; j.tile0 = tiles;
    tiles += (K / 64) * (N / 64);
  };
  const float* ng = p.norm_g;
  job(p.fn_w_in, ng, p.Wfn + 2048L * 1024, 2048, 1024, 1024, 1024, 1.f);
  job(fn_w_out, nullptr, p.Wfn_out, 1024, 0, 1024, 1024, 1.f);
  job(na_w_in, ng + 1024, p.Wna, 4096, 0, 1024, 1024, 0.17677669529663687f);
  job(na_w_in, ng + 1024, p.Wna + 1024L * 1024, 4096, 1024, 1024, 3072, 1.f);
  job(na_w_out, nullptr, p.Wna_out, 1024, 0, 1024, 1024, 1.f);
  job(mla_w_in, ng + 2048, p.Wmla_in, 1728, 0, 1024, 704, 1.f);
  job(mla_w_in, ng + 2048, p.Wmla_z, 1728, 704, 1024, 1024, 1.f);
  job(mla_w_uq, mla_g_q, p.Wuq, 1536, 0, 384, 1536, 0.07216878364870322f * 1.4426950408889634f);
  for (int h = 0; h < 8; ++h)
    for (int part = 0; part < 2; ++part)
      job(mla_w_ukv, mla_g_kv, p.Wukv + (long)(part * 1024 + h * 128) * 256, 2048, h * 256 + part * 128, 256, 128, 1.f);
  job(mla_w_out, nullptr, p.Wmla_out, 1024, 0, 1024, 1024, 1.f);
  job(hg_w_in, ng + 3072, p.Whg, 5120, 0, 1024, 4096, 1.f);
  job(hg_w_in, ng + 3072, p.Whg_z, 5120, 4096, 1024, 1024, 1.f);
  job(hg_w_out, nullptr, p.Whg_out, 1024, 0, 1024, 1024, 1.f);
  for (int li = 0; li < 4; ++li) job(ple_w + (long)li * 256 * 1024, nullptr, p.Wp + (long)li * 1024 * 256, 1024, 0, 256, 1024, 1.f);
  for (int li = 0; li < 4; ++li) job(ple_gate_w + (long)li * 1024 * 1024, nullptr, p.Wg + (long)li * 1024 * 1024, 1024, 0, 1024, 1024, 1.f);
  p.njobs = nj; p.ntjt = tiles;
  void* args[] = {&p};
  hipError_t e = hipLaunchCooperativeKernel((void*)fwd_megakernel, dim3(grid_blocks), dim3(NTHR), args, 0, stream);
  if (e != hipSuccess) fprintf(stderr, "cooperative launch failed: %s (grid %d)\n", hipGetErrorString(e), grid_blocks);
}
```

```cpp
#include <hip/hip_runtime.h>
#include <hip/hip_fp16.h>
#include <hip/hip_cooperative_groups.h>
#include <cstdio>
#include <cstring>
namespace cg = cooperative_groups;

#define DI __device__ __forceinline__
typedef unsigned short u16;
typedef __attribute__((ext_vector_type(8))) short bf16x8;
typedef __attribute__((ext_vector_type(4))) short s16x4;
typedef __attribute__((ext_vector_type(4))) float f32x4;
typedef __attribute__((ext_vector_type(4))) unsigned u32x4;
typedef __attribute__((ext_vector_type(2))) unsigned u32x2;

constexpr int T_TOK = 81920;
constexpr int TP = 16384;
constexpr long SL = (long)T_TOK * 1024 * 2;
constexpr int NTHR = 512;
constexpr int SMEM_BYTES = 147456;

#define MFMA16(a, b, c) __builtin_amdgcn_mfma_f32_16x16x32_bf16((a), (b), (c), 0, 0, 0)

DI int tid_opaque() { int t = threadIdx.x; asm volatile("" : "+v"(t)); return t; }
typedef __attribute__((ext_vector_type(2))) __bf16 bf16x2_t;
typedef __attribute__((ext_vector_type(2))) float f32x2_t;
DI unsigned pack2(float a, float b) { f32x2_t v = {a, b}; return __builtin_bit_cast(unsigned, __builtin_convertvector(v, bf16x2_t)); }
DI u16 f2bf(float x) { return (u16)(pack2(x, 0.f) & 0xffffu); }
DI float bf2f(u16 v) { return __uint_as_float(((unsigned)v) << 16); }
DI float bflo(unsigned u) { return __uint_as_float(u << 16); }
DI float bfhi(unsigned u) { return __uint_as_float(u & 0xffff0000u); }
DI float sigm(float v) { return __builtin_amdgcn_rcpf(1.f + __expf(-v)); }
DI float silu(float v) { return v * __builtin_amdgcn_rcpf(1.f + __expf(-v)); }
DI u32x2 pack4(float a, float b, float c, float d) { u32x2 r; r.x = pack2(a, b); r.y = pack2(c, d); return r; }
DI bf16x8 pack8(f32x4 a, f32x4 b) {
  u32x4 r; r.x = pack2(a[0], a[1]); r.y = pack2(a[2], a[3]); r.z = pack2(b[0], b[1]); r.w = pack2(b[2], b[3]);
  return __builtin_bit_cast(bf16x8, r);
}
DI bf16x8 cat8(s16x4 lo, s16x4 hi) { return __builtin_shufflevector(lo, hi, 0, 1, 2, 3, 4, 5, 6, 7); }

struct TJob { const float* src; const float* g; u16* dst; int ld; int col0; int K; int N; float scale; int tile0; };

struct Params {
  const float *x_prompt, *x_sample, *p_prompt, *p_sample, *norm_g, *fn_w_in, *fn_w_mix, *na_rpb, *hg_lb_raw, *hg_g_out, *final_g;
  float* out;
  u16 *buf0, *buf1;
  unsigned char* proj;
  u16 *Wfn, *Wfn_out, *Wna, *Wna_out, *Wmla_in, *Wmla_z, *Wuq, *Wukv, *Wmla_out, *Whg, *Whg_z, *Whg_out, *Wp, *Wg;
  float *CW, *rope, *ssq, *ssq_q, *ssq_kv, *lb;
  unsigned* bar;
  int njobs, ntjt;
  TJob jobs[40];
};

#define LDS_PTR(p) ((__attribute__((address_space(3))) unsigned*)(p))
template <int PIPE>
DI void gemm_loop_g(const u16* __restrict__ Xp, long ldx_l, long ldx_i, long kxs,
                    const u16* __restrict__ Yp, long ldy_l, long ldy_i, long kys, int K,
                    f32x4 (&acc)[4][8], unsigned char* smem) {
  const int t = tid_opaque(), l = t & 63, w = __builtin_amdgcn_readfirstlane(t >> 6), wx = w >> 1, wy = w & 1;
  const int lrow = t >> 3, gch = (t & 7) ^ ((t >> 4) & 7);
  const u16* xs = Xp + (long)lrow * ldx_l + gch * 8;
  const u16* ys = Yp + (long)lrow * ldy_l + gch * 8;
  const int fsw = (l >> 1) & 7, lg = l >> 4;
  const unsigned fr0 = (l & 15) * 128 + ((lg ^ fsw) << 4);
  const unsigned fr1 = (l & 15) * 128 + (((lg + 4) ^ fsw) << 4);
  const unsigned ub = wx * 8192, vb = 32768 + wy * 16384;
  const int nk = K >> 6;
  const int rot = (int)((blockIdx.x >> 3) + (blockIdx.x & 7) * 5) % nk;
  auto issue = [&](int kt0, int stage) {
    int kt = kt0 + rot; if (kt >= nk) kt -= nk;
    unsigned char* sb = smem + stage * 65536 + t * 16;
#pragma unroll
    for (int i = 0; i < 4; ++i)
      __builtin_amdgcn_global_load_lds((const unsigned*)(xs + i * ldx_i + kt * kxs), LDS_PTR(sb + i * 8192), 16, 0, 0);
#pragma unroll
    for (int i = 0; i < 4; ++i)
      __builtin_amdgcn_global_load_lds((const unsigned*)(ys + i * ldy_i + kt * kys), LDS_PTR(sb + 32768 + i * 8192), 16, 0, 0);
  };
  __syncthreads();
  issue(0, 0);
  asm volatile("s_waitcnt vmcnt(0)" ::: "memory");
  __syncthreads();
#pragma unroll 1
  for (int kt = 0; kt < nk; ++kt) {
    const unsigned char* cur = smem + (kt & 1) * 65536;
    if (kt + 1 < nk) issue(kt + 1, (kt + 1) & 1);
    if (PIPE) {
      bf16x8 u0[4], u1[4], vf[8];
#pragma unroll
      for (int i = 0; i < 4; ++i) u0[i] = *(const bf16x8*)(cur + ub + i * 2048 + fr0);
#pragma unroll
      for (int j = 0; j < 8; ++j) vf[j] = *(const bf16x8*)(cur + vb + j * 2048 + fr0);
#pragma unroll
      for (int j = 0; j < 8; ++j) {
#pragma unroll
        for (int i = 0; i < 4; ++i) acc[i][j] = MFMA16(u0[i], vf[j], acc[i][j]);
        vf[j] = *(const bf16x8*)(cur + vb + j * 2048 + fr1);
        if (j < 4) u1[j] = *(const bf16x8*)(cur + ub + j * 2048 + fr1);
        if (j & 1) __builtin_amdgcn_sched_barrier(0);
      }
#pragma unroll
      for (int j = 0; j < 8; ++j)
#pragma unroll
        for (int i = 0; i < 4; ++i) acc[i][j] = MFMA16(u1[i], vf[j], acc[i][j]);
    }
    else {
#pragma unroll
      for (int ks = 0; ks < 2; ++ks) {
        const unsigned fr = ks ? fr1 : fr0;
        bf16x8 uf[4], vf[8];
#pragma unroll
        for (int i = 0; i < 4; ++i) uf[i] = *(const bf16x8*)(cur + ub + i * 2048 + fr);
#pragma unroll
        for (int j = 0; j < 8; ++j) vf[j] = *(const bf16x8*)(cur + vb + j * 2048 + fr);
#pragma unroll
        for (int i = 0; i < 4; ++i)
#pragma unroll
          for (int j = 0; j < 8; ++j) acc[i][j] = MFMA16(uf[i], vf[j], acc[i][j]);
      }
    }
    asm volatile("s_waitcnt vmcnt(0)" ::: "memory");
    __syncthreads();
  }
}

DI void gemm_loop(const u16* __restrict__ Xp, long ldx, const u16* __restrict__ Yp, long ldy, int K,
                  f32x4 (&acc)[4][8], unsigned char* smem) {
  gemm_loop_g<1>(Xp, ldx, 64 * ldx, 64, Yp, ldy, 64 * ldy, 64, K, acc, smem);
}

DI void zero_acc(f32x4 (&acc)[4][8]) {
#pragma unroll
  for (int i = 0; i < 4; ++i)
#pragma unroll
    for (int j = 0; j < 8; ++j) acc[i][j] = f32x4{0.f, 0.f, 0.f, 0.f};
}

#define EPI_STD_BEGIN                                                        \
  _Pragma("unroll") for (int j = 0; j < 8; ++j) _Pragma("unroll") for (int i = 0; i < 4; ++i) { \
    const int n4 = n0 + wx * 64 + i * 16 + lg * 4;                           \
    const int m = m0 + wy * 128 + j * 16 + lq;                               \
    const f32x4 v = acc[i][j];
#define EPI_TR_BEGIN                                                         \
  _Pragma("unroll") for (int j = 0; j < 8; ++j) _Pragma("unroll") for (int i = 0; i < 4; ++i) { \
    const int m4 = m0 + wx * 64 + i * 16 + lg * 4;                           \
    const int n = n0 + wy * 128 + j * 16 + lq;                               \
    const f32x4 v = acc[i][j];
#define EPI_END if (i == 3 && (j & 3) == 3) __builtin_amdgcn_sched_barrier(0); }

DI float rstd_of(const float* ssq, int m, float invn) { return rsqrtf(ssq[m] * invn + 1e-6f); }

DI void prep_rows(const Params& p) {
  const int tt_ = tid_opaque();
  const int l = tt_ & 63, gw = blockIdx.x * 8 + (tt_ >> 6), nw = gridDim.x * 8;
  for (int row = gw; row < T_TOK; row += nw) {
    const float* src = row < TP ? p.x_prompt + (long)row * 1024 : p.x_sample + (long)(row - TP) * 1024;
    float4 v[4];
    float s = 0.f;
#pragma unroll
    for (int i = 0; i < 4; ++i) {
      v[i] = ((const float4*)src)[l + 64 * i];
      s += v[i].x * v[i].x + v[i].y * v[i].y + v[i].z * v[i].z + v[i].w * v[i].w;
    }
#pragma unroll
    for (int o = 1; o < 64; o <<= 1) s += __shfl_xor(s, o);
#pragma unroll
    for (int i = 0; i < 4; ++i) {
      *(u32x2*)(p.buf0 + (long)row * 1024 + (l + 64 * i) * 4) = pack4(v[i].x, v[i].y, v[i].z, v[i].w);
    }
    if (l == 0) p.ssq[row] = s;
  }
}

DI void prep_transposes(const Params& p, unsigned char* smem) {
  float* ts = (float*)smem;
  const int t = tid_opaque();
  for (int id = blockIdx.x; id < p.ntjt; id += gridDim.x) {
    int ji = 0;
    while (ji + 1 < p.njobs && id >= p.jobs[ji + 1].tile0) ++ji;
    const TJob jb = p.jobs[ji];
    const int loc = id - jb.tile0, tn_n = jb.N >> 6;
    const int tk = loc / tn_n, tn = loc - tk * tn_n;
    {
      const int r = t >> 4, c4 = (t & 15) * 4;
#pragma unroll
      for (int hh = 0; hh < 2; ++hh) {
        const int k = tk * 64 + r + 32 * hh;
        float4 v = *(const float4*)(jb.src + (long)k * jb.ld + jb.col0 + tn * 64 + c4);
        const float gk = jb.g ? jb.g[k] * jb.scale : jb.scale;
        float* d = ts + (r + 32 * hh) * 65 + c4;
        d[0] = v.x * gk; d[1] = v.y * gk; d[2] = v.z * gk; d[3] = v.w * gk;
      }
    }
    __syncthreads();
    {
      const int n = t >> 3, k8 = (t & 7) * 8;
      u32x4 o;
      o.x = pack2(ts[(k8 + 0) * 65 + n], ts[(k8 + 1) * 65 + n]);
      o.y = pack2(ts[(k8 + 2) * 65 + n], ts[(k8 + 3) * 65 + n]);
      o.z = pack2(ts[(k8 + 4) * 65 + n], ts[(k8 + 5) * 65 + n]);
      o.w = pack2(ts[(k8 + 6) * 65 + n], ts[(k8 + 7) * 65 + n]);
      *(u32x4*)(jb.dst + (long)(tn * 64 + n) * jb.K + tk * 64 + k8) = o;
    }
    __syncthreads();
  }
}

DI void prep_misc(const Params& p, unsigned char* smem) {
  const long gt = (long)blockIdx.x * NTHR + tid_opaque(), gn = (long)gridDim.x * NTHR;
  {
    u16* F2 = (u16*)(p.proj + 3 * SL); u16* G = F2 + 256 * 128; float* tw = (float*)(G + 256 * 128);
    for (long id = gt; id < 256L * 128; id += gn) {
      const int row = (int)(id >> 7), kk = (int)(id & 127), b = kk & 63, hi = kk >> 6;
      float f2 = 0.f, gg = 0.f;
      if (row < 128) {
        const int v = row & 63, im = row >> 6;
        float sn, cs;
        sincospif((float)((v * b) & 63) * (1.f / 32.f), &sn, &cs);
        f2 = (im ? (hi ? cs : sn) : (hi ? -sn : cs)) * 0.125f;
        if (row < 64) gg = (hi ? -sn : cs) * 0.125f;
      }
      F2[id] = f2bf(f2); G[id] = f2bf(gg);
    }
    for (long id = gt; id < 4096; id += gn) {
      const int v = (int)(id >> 6), a = (int)(id & 63);
      float sn, cs;
      sincospif((float)(v * a) * (1.f / 2048.f), &sn, &cs);
      tw[id * 2] = cs; tw[id * 2 + 1] = sn;
    }
  }
  for (long id = gt; id < 4096L * 32; id += gn) {
    const int pos = (int)(id >> 5), i = (int)(id & 31);
    const double inv = pow(10000.0, -(double)i / 32.0);
    double sn, cs;
    sincos((double)pos * inv, &sn, &cs);
    p.rope[id * 2] = (float)cs; p.rope[id * 2 + 1] = (float)sn;
  }
  float2* cst = (float2*)smem;
  __syncthreads();
  {
    const int tl = tid_opaque();
    if (tl < 128) { float sn, cs; sincospif((float)tl * (1.f / 64.f), &sn, &cs); cst[tl] = float2{cs, sn}; }
  }
  __syncthreads();
  for (long id = gt; id < 8L * 128 * 256; id += gn) {
    const int col = (int)(id & 255), c = (int)((id >> 8) & 127), g = (int)(id >> 15);
    const int d = col & 127, is_sin = col >> 7;
    float a = 0.f;
    for (int lq = 0; lq < 128; ++lq) {
      const float2 t2 = cst[(lq * c) & 127];
      a += (is_sin ? t2.y : t2.x) * p.fn_w_mix[((long)g * 128 + lq) * 128 + d];
    }
    p.CW[id] = a * 0.08838834764831845f;
  }
  __syncthreads();
  for (long id = gt; id < 2048; id += gn) {
    float r0 = p.hg_lb_raw[id], r1 = p.hg_lb_raw[2048 + id], r2 = p.hg_lb_raw[4096 + id], r3 = p.hg_lb_raw[6144 + id];
    float mx = fmaxf(fmaxf(r0, r1), fmaxf(r2, r3));
    float e0 = __expf(r0 - mx), e1 = __expf(r1 - mx), e2 = __expf(r2 - mx), e3 = __expf(r3 - mx);
    p.lb[id] = (e1 + e2 + e3) / (e0 + e1 + e2 + e3);
  }
  for (long id = gt; id < 4L * T_TOK; id += gn) p.ssq[T_TOK + id] = 0.f;
  for (long id = gt; id < T_TOK; id += gn) { p.ssq_q[id] = 0.f; p.ssq_kv[id] = 0.f; }
  for (long id = gt; id < 64L * 1024; id += gn) p.Wmla_in[704L * 1024 + id] = 0;
}

DI void prep_wprime(const Params& p) {
  const long gt = (long)blockIdx.x * NTHR + tid_opaque(), gn = (long)gridDim.x * NTHR;
  for (long id = gt; id < 2048L * 1024; id += gn) {
    const int k = (int)(id & 1023), np = (int)(id >> 10), g = np >> 8, col = np & 255;
    const float4* wi = (const float4*)(p.fn_w_in + (long)k * 2048 + g * 128);
    const float* cw = p.CW + (long)g * 128 * 256 + col;
    float a = 0.f;
    for (int c4 = 0; c4 < 32; ++c4) {
      float4 v = wi[c4];
      a += v.x * cw[(c4 * 4 + 0) * 256] + v.y * cw[(c4 * 4 + 1) * 256] + v.z * cw[(c4 * 4 + 2) * 256] + v.w * cw[(c4 * 4 + 3) * 256];
    }
    p.Wfn[id] = f2bf(a * p.norm_g[k]);
  }
}

enum { M_FN_IN, M_SEQ, M_OUT, M_PLE, M_NA_IN, M_MLA_IN, M_MLA_UQ, M_MLA_UKV, M_ZPASS, M_HG_IN, M_FFT1 = 14, M_FFT3 = 15 };

struct GP {
  const u16* A; long lda; const u16* W; int K; int ntn; int ntiles;
  void *d0, *d1, *d2, *d3;
  const float* ssq_in; float* ssq_out; float* ssq_out2;
  const u16* W2; int li;
};

#ifndef PH_MASK
#define PH_MASK 0xffffffffu
#endif
template <int MODE>
DI void gemm_phase(const Params& p, const GP& g, unsigned char* smem) {
  if (!((PH_MASK >> MODE) & 1u)) return;
  const int t = tid_opaque(), l = t & 63, w = __builtin_amdgcn_readfirstlane(t >> 6), wx = w >> 1, wy = w & 1, lq = l & 15, lg = l >> 4;
  const int xcd = blockIdx.x & 7, slot = blockIdx.x >> 3, nslot = gridDim.x >> 3;
  const int nent = (g.ntiles >> 3);
  for (int e = slot; e < nent; e += nslot) {
    int mt, nt;
    const u16* Ab = g.A; const u16* Wb = g.W;
    int bsel = 0;
    {
      const int ml = e / g.ntn;
      nt = e - ml * g.ntn;
      mt = xcd + 8 * ml;
    }
    if (MODE == M_SEQ) { bsel = mt >> 4; mt &= 15; Wb = g.W + (long)bsel * 1024 * 8192; }
    const int m0 = mt * 256, n0 = nt * 256;
    f32x4 acc[4][8];
    zero_acc(acc);
    int transposed = 0;
    if (MODE == M_FN_IN) transposed = nt < 8;
    if (MODE == M_NA_IN) transposed = (nt >= 8 && nt < 12);
    if (MODE == M_MLA_UKV) transposed = nt >= 4;
    if (MODE == M_HG_IN) transposed = nt >= 12;
    if (MODE == M_PLE) {
      const u16* pb = (const u16*)g.d1;
      gemm_loop(g.W2 + (long)n0 * 256, 256, pb + (long)m0 * 256, 256, 256, acc, smem);
      u16* xb = (u16*)g.d0;
      EPI_STD_BEGIN
        *(u32x2*)(xb + (long)m * 1024 + n4) = pack4(v[0], v[1], v[2], v[3]);
      EPI_END
      zero_acc(acc);
    }
    if (MODE == M_FFT1) {
      const int bt = mt >> 8, cg = mt & 255;
      gemm_loop_g<0>(Ab + ((long)(bt * 1024 + cg * 4)) * 8192, 64, 8192, 4096, Wb, 128, 64 * 128, 64, 128, acc, smem);
    } else if (MODE == M_FFT3) {
      const int bt = mt >> 8, v = (mt >> 2) & 63, cq = mt & 3;
      gemm_loop(Ab + (((long)(bt * 64 + v)) * 1024 + cq * 256) * 128, 128, Wb, 128, 128, acc, smem);
    } else if (MODE == M_FN_IN && transposed) {
      const u16* Ap = Ab + ((long)(mt >> 4) * 4096 + (mt & 15) * 4) * g.lda;
      gemm_loop_g<1>(Ap, 64 * g.lda, g.lda, 64, Wb + (long)n0 * g.K, g.K, 64L * g.K, 64, g.K, acc, smem);
    } else {
      const u16* Ap = Ab + (long)m0 * g.lda; const u16* Wp = Wb + (long)n0 * g.K;
      if (transposed) gemm_loop(Ap, g.lda, Wp, g.K, g.K, acc, smem);
      else gemm_loop(Wp, g.K, Ap, g.lda, g.K, acc, smem);
    }

    if (MODE == M_FN_IN) {
      if (transposed) {
        u16* Pt = (u16*)g.d0;
        const int bt = mt >> 4, a = (mt & 15) * 4 + wx;
        EPI_TR_BEGIN
          const int grp = n >> 8, half = (n >> 7) & 1, c = grp * 128 + (n & 127);
          const int b0 = i * 16 + lg * 4;
          const int tok = bt * 4096 + a + 64 * b0;
          (void)m4;
          *(u32x2*)(Pt + (((long)bt * 1024 + c) * 2 + half) * 4096 + a * 64 + b0) =
              pack4(v[0] * rstd_of(g.ssq_in, tok, 1.f / 1024), v[1] * rstd_of(g.ssq_in, tok + 64, 1.f / 1024),
                    v[2] * rstd_of(g.ssq_in, tok + 128, 1.f / 1024), v[3] * rstd_of(g.ssq_in, tok + 192, 1.f / 1024));
        EPI_END
      } else {
        u16* z = (u16*)g.d1;
        EPI_STD_BEGIN
          const float rs = rstd_of(g.ssq_in, m, 1.f / 1024);
          *(u32x2*)(z + (long)m * 1024 + (n4 - 2048)) = pack4(v[0] * rs, v[1] * rs, v[2] * rs, v[3] * rs);
        EPI_END
      }
    } else if (MODE == M_FFT1) {
      if (wy == 0) {
        u16* Zs = (u16*)g.d0; const float* tw = (const float*)g.d1;
        const int bt = mt >> 8, c = (mt & 255) * 4 + wx;
#pragma unroll
        for (int jj = 0; jj < 4; ++jj)
#pragma unroll
          for (int i = 0; i < 4; ++i) {
            const int a4 = i * 16 + lg * 4, v = jj * 16 + lq;
            const float4 t0 = *(const float4*)(tw + (v * 64 + a4) * 2), t1 = *(const float4*)(tw + (v * 64 + a4) * 2 + 4);
            const f32x4 zr = acc[i][jj], zi = acc[i][jj + 4];
            const long base = ((((long)(bt * 64 + v)) * 1024 + c) * 2) * 64 + a4;
            *(u32x2*)(Zs + base) = pack4(zr[0] * t0.x - zi[0] * t0.y, zr[1] * t0.z - zi[1] * t0.w,
                                         zr[2] * t1.x - zi[2] * t1.y, zr[3] * t1.z - zi[3] * t1.w);
            *(u32x2*)(Zs + base + 64) = pack4(zr[0] * t0.y + zi[0] * t0.x, zr[1] * t0.w + zi[1] * t0.z,
                                              zr[2] * t1.y + zi[2] * t1.x, zr[3] * t1.w + zi[3] * t1.z);
            __builtin_amdgcn_sched_barrier(0);
          }
      }
    } else if (MODE == M_FFT3) {
      if (wy == 0) {
        u16* og = (u16*)g.d0; const u16* z = (const u16*)g.d1;
        const int bt = mt >> 8, v = (mt >> 2) & 63, cq = mt & 3;
#pragma unroll
        for (int j = 0; j < 4; ++j)
#pragma unroll
          for (int i = 0; i < 4; ++i) {
            const int c4 = cq * 256 + wx * 64 + i * 16 + lg * 4, u = j * 16 + lq;
            const long o = ((long)bt * 4096 + 64 * u + v) * 1024 + c4;
            const f32x4 val = acc[i][j];
            const u32x2 zz = *(const u32x2*)(z + o);
            *(u32x2*)(og + o) = pack4(val[0] * silu(bflo(zz.x)), val[1] * silu(bfhi(zz.x)), val[2] * silu(bflo(zz.y)), val[3] * silu(bfhi(zz.y)));
            if (i == 3) __builtin_amdgcn_sched_barrier(0);
          }
      }
    } else if (MODE == M_SEQ) {
      u16* og = (u16*)g.d0; const u16* z = (const u16*)g.d1;
      EPI_STD_BEGIN
        const long o = ((long)bsel * 4096 + m) * 1024 + n4;
        const u32x2 zz = *(const u32x2*)(z + o);
        *(u32x2*)(og + o) = pack4(v[0] * silu(bflo(zz.x)), v[1] * silu(bfhi(zz.x)), v[2] * silu(bflo(zz.y)), v[3] * silu(bfhi(zz.y)));
      EPI_END
    } else if (MODE == M_OUT) {
      u16* xb = (u16*)g.d0;
      const float* xin = g.li ? p.out : (m0 < TP ? p.x_prompt : p.x_sample - (long)TP * 1024);
      EPI_STD_BEGIN
        float4* xp = (float4*)(p.out + (long)m * 1024 + n4);
        float4 xv = *(const float4*)(xin + (long)m * 1024 + n4);
        xv.x += v[0]; xv.y += v[1]; xv.z += v[2]; xv.w += v[3];
        *xp = xv;
        *(u32x2*)(xb + (long)m * 1024 + n4) = pack4(xv.x, xv.y, xv.z, xv.w);
      EPI_END
    } else if (MODE == M_PLE) {
      u16* xb = (u16*)g.d0;
      asm volatile("" : "+s"(xb));
#pragma unroll
      for (int j = 0; j < 8; ++j) {
        const int m = m0 + wy * 128 + j * 16 + lq;
        float sq = 0.f;
#pragma unroll
        for (int i = 0; i < 4; ++i) {
          const int n4 = n0 + wx * 64 + i * 16 + lg * 4;
          const f32x4 v = acc[i][j];
          const u32x2 pv = *(const u32x2*)(xb + (long)m * 1024 + n4);
          float4* xp = (float4*)(p.out + (long)m * 1024 + n4);
          float4 xv = *xp;
          xv.x += sigm(v[0]) * bflo(pv.x); xv.y += sigm(v[1]) * bfhi(pv.x); xv.z += sigm(v[2]) * bflo(pv.y); xv.w += sigm(v[3]) * bfhi(pv.y);
          *xp = xv;
          if (g.li != 3) *(u32x2*)(xb + (long)m * 1024 + n4) = pack4(xv.x, xv.y, xv.z, xv.w);
          sq += xv.x * xv.x + xv.y * xv.y + xv.z * xv.z + xv.w * xv.w;
        }
        sq += __shfl_xor(sq, 16);
        sq += __shfl_xor(sq, 32);
        if (lg == 0) atomicAdd(g.ssq_out + m, sq);
        __builtin_amdgcn_sched_barrier(0);
      }
    } else if (MODE == M_NA_IN) {
      if (transposed) {
        u16* Vt = (u16*)g.d2;
        EPI_TR_BEGIN
          const int b = m4 >> 12, s = m4 & 4095;
          *(u32x2*)(Vt + ((long)b * 1024 + (n - 2048)) * 4096 + s) =
              pack4(v[0] * rstd_of(g.ssq_in, m4, 1.f / 1024), v[1] * rstd_of(g.ssq_in, m4 + 1, 1.f / 1024),
                    v[2] * rstd_of(g.ssq_in, m4 + 2, 1.f / 1024), v[3] * rstd_of(g.ssq_in, m4 + 3, 1.f / 1024));
        EPI_END
      } else {
        u16* dst = (u16*)((unsigned char*)g.d0 + (nt < 4 ? 0L : (nt < 8 ? SL : 3 * SL)));
        const int nb = nt < 4 ? 0 : (nt < 8 ? 1024 : 3072);
        EPI_STD_BEGIN
          const float rs = rstd_of(g.ssq_in, m, 1.f / 1024);
          *(u32x2*)(dst + (long)m * 1024 + (n4 - nb)) = pack4(v[0] * rs, v[1] * rs, v[2] * rs, v[3] * rs);
        EPI_END
      }
    } else if (MODE == M_MLA_IN) {
      const int u = (n0 >> 6) + wx;
      if (u < 10) {
        u16* dst = (u16*)g.d0 + (u < 6 ? 0L : (long)T_TOK * 384);
        const int ldd = u < 6 ? 384 : 256, nb = u < 6 ? 0 : 384;
        float* sqo = g.ssq_out + (u < 6 ? 0 : T_TOK);
#pragma unroll
        for (int j = 0; j < 8; ++j) {
          const int m = m0 + wy * 128 + j * 16 + lq;
          const float rs = rstd_of(g.ssq_in, m, 1.f / 1024);
          float sq = 0.f;
#pragma unroll
          for (int i = 0; i < 4; ++i) {
            const int n4 = n0 + wx * 64 + i * 16 + lg * 4;
            const f32x4 v = acc[i][j] * rs;
            *(u32x2*)(dst + (long)m * ldd + (n4 - nb)) = pack4(v[0], v[1], v[2], v[3]);
            sq += v[0] * v[0] + v[1] * v[1] + v[2] * v[2] + v[3] * v[3];
          }
          sq += __shfl_xor(sq, 16);
          sq += __shfl_xor(sq, 32);
          if (lg == 0) atomicAdd(sqo + m, sq);
        }
      } else if (u == 10) {
        u16* kpe = (u16*)g.d2;
#pragma unroll
        for (int j = 0; j < 8; ++j)
#pragma unroll
          for (int i = 0; i < 2; ++i) {
            const int m = m0 + wy * 128 + j * 16 + lq, pos = m & 4095;
            const float rs = rstd_of(g.ssq_in, m, 1.f / 1024);
            const int f0 = i * 16 + lg * 4;
            const f32x4 a = acc[i][j], bq = acc[i + 2][j];
            float lo[4], hi[4];
#pragma unroll
            for (int r = 0; r < 4; ++r) {
              const float2 cssn = *(const float2*)(p.rope + ((long)pos * 32 + f0 + r) * 2);
              const float x1 = a[r] * rs, x2 = bq[r] * rs;
              lo[r] = x1 * cssn.x - x2 * cssn.y;
              hi[r] = x1 * cssn.y + x2 * cssn.x;
            }
            *(u32x2*)(kpe + (long)m * 64 + f0) = pack4(lo[0], lo[1], lo[2], lo[3]);
            *(u32x2*)(kpe + (long)m * 64 + 32 + f0) = pack4(hi[0], hi[1], hi[2], hi[3]);
          }
      }
    } else if (MODE == M_MLA_UQ) {
      u16* qo = (u16*)g.d0;
      const int slab = (n0 >> 6) + wx;
      if (slab % 3 == 2) {
#pragma unroll
        for (int j = 0; j < 8; ++j)
#pragma unroll
          for (int i = 0; i < 2; ++i) {
            const int m = m0 + wy * 128 + j * 16 + lq, pos = m & 4095;
            const float rs = rstd_of(g.ssq_in, m, 1.f / 384);
            const int f0 = i * 16 + lg * 4;
            const f32x4 a = acc[i][j], bq = acc[i + 2][j];
            float lo[4], hi[4];
#pragma unroll
            for (int r = 0; r < 4; ++r) {
              const float2 cssn = *(const float2*)(p.rope + ((long)pos * 32 + f0 + r) * 2);
              const float x1 = a[r] * rs, x2 = bq[r] * rs;
              lo[r] = x1 * cssn.x - x2 * cssn.y;
              hi[r] = x1 * cssn.y + x2 * cssn.x;
            }
            *(u32x2*)(qo + (long)m * 1536 + slab * 64 + f0) = pack4(lo[0], lo[1], lo[2], lo[3]);
            *(u32x2*)(qo + (long)m * 1536 + slab * 64 + 32 + f0) = pack4(hi[0], hi[1], hi[2], hi[3]);
          }
      } else {
        EPI_STD_BEGIN
          const float rs = rstd_of(g.ssq_in, m, 1.f / 384);
          *(u32x2*)(qo + (long)m * 1536 + n4) = pack4(v[0] * rs, v[1] * rs, v[2] * rs, v[3] * rs);
        EPI_END
      }
    } else if (MODE == M_MLA_UKV) {
      if (transposed) {
        u16* Vt = (u16*)g.d1;
        EPI_TR_BEGIN
          const int b = m4 >> 12, s = m4 & 4095;
          *(u32x2*)(Vt + ((long)b * 1024 + (n - 1024)) * 4096 + s) =
              pack4(v[0] * rstd_of(g.ssq_in, m4, 1.f / 256), v[1] * rstd_of(g.ssq_in, m4 + 1, 1.f / 256),
                    v[2] * rstd_of(g.ssq_in, m4 + 2, 1.f / 256), v[3] * rstd_of(g.ssq_in, m4 + 3, 1.f / 256));
        EPI_END
      } else {
        u16* kn = (u16*)g.d0;
        EPI_STD_BEGIN
          const float rs = rstd_of(g.ssq_in, m, 1.f / 256);
          *(u32x2*)(kn + (long)m * 1024 + n4) = pack4(v[0] * rs, v[1] * rs, v[2] * rs, v[3] * rs);
        EPI_END
      }
    } else if (MODE == M_ZPASS) {
      u16* og = (u16*)g.d0;
      EPI_STD_BEGIN
        const float rs = rstd_of(g.ssq_in, m, 1.f / 1024);
        u32x2* op = (u32x2*)(og + (long)m * 1024 + n4);
        const u32x2 ov = *op;
        *op = pack4(bflo(ov.x) * silu(v[0] * rs), bfhi(ov.x) * silu(v[1] * rs), bflo(ov.y) * silu(v[2] * rs), bfhi(ov.y) * silu(v[3] * rs));
      EPI_END
    } else if (MODE == M_HG_IN) {
      if (transposed) {
        u16* iT = (u16*)g.d3;
        EPI_TR_BEGIN
          const int b = m4 >> 12, s = m4 & 4095;
          *(u32x2*)(iT + ((long)b * 1024 + (n - 3072)) * 4096 + s) =
              pack4(v[0] * rstd_of(g.ssq_in, m4, 1.f / 1024), v[1] * rstd_of(g.ssq_in, m4 + 1, 1.f / 1024),
                    v[2] * rstd_of(g.ssq_in, m4 + 2, 1.f / 1024), v[3] * rstd_of(g.ssq_in, m4 + 3, 1.f / 1024));
        EPI_END
      } else if (nt < 4) {
        u16* qo = (u16*)g.d0;
        EPI_STD_BEGIN
          const float rs = rstd_of(g.ssq_in, m, 1.f / 1024);
          *(u32x2*)(qo + (long)m * 1024 + n4) = pack4(silu(v[0] * rs), silu(v[1] * rs), silu(v[2] * rs), silu(v[3] * rs));
        EPI_END
      } else {
        const int dir = nt >= 8;
        __half* go = (__half*)((unsigned char*)g.d1 + (dir ? SL : 0L));
        EPI_STD_BEGIN
          const float rs = rstd_of(g.ssq_in, m, 1.f / 1024);
          const int c = n4 - 1024 - dir * 1024;
          const float4 lbv = *(const float4*)(p.lb + dir * 1024 + c);
          __half2 h01, h23;
          h01.x = __float2half(__logf(lbv.x + (1.f - lbv.x) * sigm(v[0] * rs)));
          h01.y = __float2half(__logf(lbv.y + (1.f - lbv.y) * sigm(v[1] * rs)));
          h23.x = __float2half(__logf(lbv.z + (1.f - lbv.z) * sigm(v[2] * rs)));
          h23.y = __float2half(__logf(lbv.w + (1.f - lbv.w) * sigm(v[3] * rs)));
          __half2* dp = (__half2*)(go + (long)m * 1024 + c);
          dp[0] = h01; dp[1] = h23;
        EPI_END
      }
    }
  }
}

DI void convert_p(const Params& p, int li, u16* dst) {
  const long gt = (long)blockIdx.x * NTHR + tid_opaque(), gn = (long)gridDim.x * NTHR;
  for (long id = gt; id < (long)T_TOK * 64; id += gn) {
    const long m = id >> 6; const int c4 = (int)(id & 63) * 4;
    const float* src = (m < TP) ? p.p_prompt + ((long)li * TP + m) * 256 : p.p_sample + ((long)li * (T_TOK - TP) + (m - TP)) * 256;
    const float4 v = *(const float4*)(src + c4);
    *(u32x2*)(dst + m * 256 + c4) = pack4(v.x, v.y, v.z, v.w);
  }
}

DI void na_phase(const Params& p, const u16* q, const u16* k, const u16* vt, const u16* z, u16* og, unsigned char* smem) {
  if (!((PH_MASK >> 10) & 1u)) return;
  const int t = tid_opaque(), l = t & 63, w = __builtin_amdgcn_readfirstlane(t >> 6), lq = l & 15, lg = l >> 4;
  const int hh = w >> 1, jb = (w & 1) * 2;
  float* rp = (float*)(smem + 131072) + hh * 480;
  constexpr int NSTG = 32768;
  int cur_hg = -1;
  for (int item = blockIdx.x; item < 20 * 64 * 8; item += gridDim.x) {
    const int hg = item & 7, r = (item >> 3) & 63, b = item >> 9;
    const int h = hg * 4 + hh;
    const int rs = min(max(r - 4, 0), 56);
    __syncthreads();
    if (hg != cur_hg) {
      if (!(w & 1)) for (int i = l; i < 465; i += 64) rp[i] = p.na_rpb[h * 465 + i];
      cur_hg = hg;
    }
    auto issue = [&](int ri) {
      const int t2 = tid_opaque();
      unsigned char* sb = smem + (ri & 3) * NSTG + t2 * 16;
      const long tok0 = (long)b * 4096 + (rs + ri) * 64;
#pragma unroll
      for (int i = 0; i < 2; ++i) {
        const int cid = t2 + 512 * i, row = cid >> 4, c = (cid & 15) ^ (row & 15);
        __builtin_amdgcn_global_load_lds((const unsigned*)(k + (tok0 + row) * 1024 + hg * 128 + c * 8), LDS_PTR(sb + i * 8192), 16, 0, 0);
      }
#pragma unroll
      for (int i = 0; i < 2; ++i) {
        const int cid = t2 + 512 * i, row = cid >> 3, c = (cid & 7) ^ ((row >> 1) & 7);
        __builtin_amdgcn_global_load_lds((const unsigned*)(vt + ((long)(b * 1024 + hg * 128 + row)) * 4096 + (rs + ri) * 64 + c * 8),
                                         LDS_PTR(sb + 16384 + i * 8192), 16, 0, 0);
      }
    };
    bf16x8 qf[2];
#pragma unroll
    for (int jj = 0; jj < 2; ++jj)
      qf[jj] = *(const bf16x8*)(q + ((long)b * 4096 + r * 64 + (jb + jj) * 16 + lq) * 1024 + h * 32 + lg * 8);
    issue(0); issue(1); issue(2);
    f32x4 o[2][2];
    float lrun[2];
#pragma unroll
    for (int jj = 0; jj < 2; ++jj) { o[jj][0] = f32x4{0.f, 0.f, 0.f, 0.f}; o[jj][1] = f32x4{0.f, 0.f, 0.f, 0.f}; lrun[jj] = 0.f; }
#pragma unroll 1
    for (int ri = 0; ri < 8; ++ri) {
      if (ri <= 5) asm volatile("s_waitcnt vmcnt(8)" ::: "memory");
      else if (ri == 6) asm volatile("s_waitcnt vmcnt(4)" ::: "memory");
      else asm volatile("s_waitcnt vmcnt(0)" ::: "memory");
      asm volatile("s_waitcnt lgkmcnt(0)" ::: "memory");
      __builtin_amdgcn_s_barrier();
      if (ri + 3 < 8) issue(ri + 3);
      const unsigned char* Ks = smem + (ri & 3) * NSTG;
      const unsigned char* Vs = Ks + 16384;
      const int ro = rs + ri - r + 7;
#pragma unroll
      for (int jj = 0; jj < 2; ++jj) {
        const int j = jb + jj;
        const int kcs = min(max(j * 16 - 8, 0), 32);
        f32x4 sc[2];
#pragma unroll
        for (int c2 = 0; c2 < 2; ++c2) {
          const int row = kcs + c2 * 16 + lq;
          const bf16x8 kf = *(const bf16x8*)(Ks + row * 256 + (((hh * 4 + lg) ^ (row & 15)) << 4));
          sc[c2] = MFMA16(kf, qf[jj], (f32x4{0.f, 0.f, 0.f, 0.f}));
        }
        const int qcol = j * 16 + lq, win = min(max(qcol - 8, 0), 48);
        float ps = 0.f;
#pragma unroll
        for (int c2 = 0; c2 < 2; ++c2)
#pragma unroll
          for (int rr = 0; rr < 4; ++rr) {
            const int kcol = kcs + c2 * 16 + lg * 4 + rr;
            const bool valid = (kcol >= win) && (kcol < win + 16);
            const int co = min(max(kcol - qcol + 15, 0), 30);
            const float e = valid ? __expf(fminf(sc[c2][rr] + rp[ro * 31 + co], 80.f)) : 0.f;
            sc[c2][rr] = e;
            ps += e;
          }
        lrun[jj] += ps;
        const bf16x8 pf = pack8(sc[0], sc[1]);
#pragma unroll
        for (int dt = 0; dt < 2; ++dt) {
          const int vrow = hh * 32 + dt * 16 + lq, vsw = (vrow >> 1) & 7, ch = (kcs >> 3) + (lg >> 1);
          const unsigned char* vr = Vs + vrow * 128 + (lg & 1) * 8;
          const s16x4 lo = *(const s16x4*)(vr + ((ch ^ vsw) << 4));
          const s16x4 hi = *(const s16x4*)(vr + (((ch + 2) ^ vsw) << 4));
          o[jj][dt] = MFMA16(cat8(lo, hi), pf, o[jj][dt]);
        }
      }
    }
#pragma unroll
    for (int jj = 0; jj < 2; ++jj) {
      float ls = lrun[jj];
      ls += __shfl_xor(ls, 16);
      ls += __shfl_xor(ls, 32);
      const float inv = __builtin_amdgcn_rcpf(ls);
#pragma unroll
      for (int dt = 0; dt < 2; ++dt) {
        const long off = ((long)b * 4096 + r * 64 + (jb + jj) * 16 + lq) * 1024 + h * 32 + dt * 16 + lg * 4;
        const u32x2 zz = *(const u32x2*)(z + off);
        *(u32x2*)(og + off) = pack4(o[jj][dt][0] * inv * silu(bflo(zz.x)), o[jj][dt][1] * inv * silu(bfhi(zz.x)),
                                    o[jj][dt][2] * inv * silu(bflo(zz.y)), o[jj][dt][3] * inv * silu(bfhi(zz.y)));
      }
    }
  }
  __syncthreads();
}

DI void mla_attn(const u16* q, const u16* kn, const u16* kpe, const u16* vt, u16* o, unsigned char* smem) {
  if (!((PH_MASK >> 11) & 1u)) return;
  const int t = tid_opaque(), l = t & 63, w = __builtin_amdgcn_readfirstlane(t >> 6), lq = l & 15, lg = l >> 4;
  const int fsw = (lq >> 1) & 7;
  constexpr int NQT = 2, QPB = 128 * NQT, NQB = 4096 / QPB, MSTAGE = 40960;
  for (int item = blockIdx.x; item < 20 * 8 * NQB; item += gridDim.x) {
    const int qb = item % NQB, h = (item / NQB) & 7, b = item / (NQB * 8);
    const long tb = (long)b * 4096;
    bf16x8 qf[NQT][6];
#pragma unroll
    for (int qt = 0; qt < NQT; ++qt)
#pragma unroll
      for (int ks = 0; ks < 6; ++ks)
        qf[qt][ks] = *(const bf16x8*)(q + (tb + qb * QPB + w * 16 * NQT + qt * 16 + lq) * 1536 + h * 192 + ks * 32 + lg * 8);
    f32x4 oacc[8][NQT];
#pragma unroll
    for (int dt = 0; dt < 8; ++dt)
#pragma unroll
      for (int qt = 0; qt < NQT; ++qt) oacc[dt][qt] = f32x4{0.f, 0.f, 0.f, 0.f};
    float mrun[NQT], lrun[NQT];
#pragma unroll
    for (int qt = 0; qt < NQT; ++qt) { mrun[qt] = -1e30f; lrun[qt] = 0.f; }
    auto issue = [&](int kt, int stage) {
      const int t2 = tid_opaque();
      unsigned char* sb = smem + stage * MSTAGE + t2 * 16;
      const long k0 = tb + kt * 64;
#pragma unroll
      for (int i = 0; i < 3; ++i) {
        const int cid = t2 + 512 * i, row = cid / 24, c = (cid - row * 24) ^ ((row >> 1) & 7);
        const u16* src = c < 16 ? kn + (k0 + row) * 1024 + h * 128 + c * 8 : kpe + (k0 + row) * 64 + (c - 16) * 8;
        __builtin_amdgcn_global_load_lds((const unsigned*)src, LDS_PTR(sb + i * 8192), 16, 0, 0);
      }
#pragma unroll
      for (int i = 0; i < 2; ++i) {
        const int cid = t2 + 512 * i, d = cid >> 3, c = (cid & 7) ^ ((d >> 1) & 7);
        __builtin_amdgcn_global_load_lds((const unsigned*)(vt + ((long)(b * 1024 + h * 128 + d)) * 4096 + kt * 64 + c * 8),
                                         LDS_PTR(sb + 24576 + i * 8192), 16, 0, 0);
      }
    };
    __syncthreads();
    issue(0, 0);
    issue(1, 1);
    int st = 0;
#pragma unroll 1
    for (int kt = 0; kt < 64; ++kt) {
      if (kt + 1 < 64) asm volatile("s_waitcnt vmcnt(5)" ::: "memory");
      else asm volatile("s_waitcnt vmcnt(0)" ::: "memory");
      __builtin_amdgcn_s_barrier();
      if (kt + 2 < 64) { int s2 = st + 2; if (s2 >= 3) s2 -= 3; issue(kt + 2, s2); }
      const unsigned char* Kt = smem + st * MSTAGE;
      const unsigned char* Vt = Kt + 24576;
      f32x4 s[4][NQT];
#pragma unroll
      for (int k16 = 0; k16 < 4; ++k16)
#pragma unroll
        for (int qt = 0; qt < NQT; ++qt) s[k16][qt] = f32x4{0.f, 0.f, 0.f, 0.f};
#pragma unroll
      for (int ks = 0; ks < 6; ++ks) {
#pragma unroll
        for (int k16 = 0; k16 < 4; ++k16) {
          const bf16x8 kf = *(const bf16x8*)(Kt + (k16 * 16 + lq) * 384 + (((ks * 4 + lg) ^ fsw) << 4));
#pragma unroll
          for (int qt = 0; qt < NQT; ++qt) s[k16][qt] = MFMA16(kf, qf[qt][ks], s[k16][qt]);
        }
        if (ks & 1) __builtin_amdgcn_sched_barrier(0);
      }
      bf16x8 pf[NQT][2];
#pragma unroll
      for (int qt = 0; qt < NQT; ++qt) {
        float ps = 0.f;
#pragma unroll
        for (int k16 = 0; k16 < 4; ++k16)
#pragma unroll
          for (int rr = 0; rr < 4; ++rr) { const float e = __builtin_amdgcn_exp2f(fminf(s[k16][qt][rr], 100.f)); s[k16][qt][rr] = e; ps += e; }
        lrun[qt] += ps;
        pf[qt][0] = pack8(s[0][qt], s[1][qt]);
        pf[qt][1] = pack8(s[2][qt], s[3][qt]);
      }
#pragma unroll
      for (int kk = 0; kk < 2; ++kk)
#pragma unroll
        for (int dt = 0; dt < 8; ++dt) {
          const unsigned char* vr = Vt + (dt * 16 + lq) * 128 + (lg & 1) * 8;
          const s16x4 lo = *(const s16x4*)(vr + (((kk * 4 + (lg >> 1)) ^ fsw) << 4));
          const s16x4 hi = *(const s16x4*)(vr + (((kk * 4 + (lg >> 1) + 2) ^ fsw) << 4));
          const bf16x8 vf = cat8(lo, hi);
#pragma unroll
          for (int qt = 0; qt < NQT; ++qt) oacc[dt][qt] = MFMA16(vf, pf[qt][kk], oacc[dt][qt]);
        }
      st = (st == 2) ? 0 : st + 1;
    }
#pragma unroll
    for (int qt = 0; qt < NQT; ++qt) {
      float ls = lrun[qt];
      ls += __shfl_xor(ls, 16);
      ls += __shfl_xor(ls, 32);
      const float inv = __builtin_amdgcn_rcpf(ls);
      const long row = (tb + qb * QPB + w * 16 * NQT + qt * 16 + lq) * 1024 + h * 128 + lg * 4;
#pragma unroll
      for (int dt = 0; dt < 8; ++dt)
        *(u32x2*)(o + row + dt * 16) = pack4(oacc[dt][qt][0] * inv, oacc[dt][qt][1] * inv, oacc[dt][qt][2] * inv, oacc[dt][qt][3] * inv);
    }
  }
}

DI u32x4 rev8(u32x4 v) {
  u32x4 r;
  r.x = (v.w >> 16) | (v.w << 16); r.y = (v.z >> 16) | (v.z << 16); r.z = (v.y >> 16) | (v.y << 16); r.w = (v.x >> 16) | (v.x << 16);
  return r;
}
DI void hg_scan(const u16* qh, const __half* gf, const __half* gb, const u16* it, const float* g_out, u16* o, unsigned char* smem) {
  if (!((PH_MASK >> 12) & 1u)) return;
  const int t = tid_opaque(), l = t & 63, w = __builtin_amdgcn_readfirstlane(t >> 6), lq = l & 15, lg = l >> 4;
  unsigned char* QT = smem;
  unsigned char* KT = smem + 16384;
  unsigned char* KH = smem + 32768;
  unsigned char* VT = smem + 49152;
  u16* RQ = (u16*)(smem + 65536);
  __half* RG = (__half*)(smem + 81920);
  float* RED = (float*)(smem + 98304);
  float* DEC = (float*)(smem + 98304 + 2048);
  float* PS = (float*)(smem + 98304 + 2048 + 512);
  const int vs = w * 16, vsw = (lq >> 1) & 7;
  const int col = t & 127, qr = t >> 7;
  for (int item = blockIdx.x; item < 160; item += gridDim.x) {
    const int b = item >> 3, h = item & 7;
    for (int dir = 0; dir < 2; ++dir) {
      const __half* gsrc = dir ? gb : gf;
      f32x4 S[8];
#pragma unroll
      for (int ct = 0; ct < 8; ++ct) S[ct] = f32x4{0.f, 0.f, 0.f, 0.f};
      u32x4 rq[2], rgv[2], rv[2];
      auto gload = [&](int step) {
        const int cidx = dir ? 63 - step : step;
        const long tok0 = (long)b * 4096 + cidx * 64;
#pragma unroll
        for (int i = 0; i < 2; ++i) {
          const int cid = t + 512 * i, row = cid >> 4, c = cid & 15;
          rq[i] = *(const u32x4*)(qh + (tok0 + row) * 1024 + h * 128 + c * 8);
          rgv[i] = *(const u32x4*)(gsrc + (tok0 + row) * 1024 + h * 128 + c * 8);
          const int vv = cid >> 3, c8 = cid & 7;
          rv[i] = *(const u32x4*)(it + ((long)(b * 1024 + h * 128 + vv)) * 4096 + cidx * 64 + c8 * 8);
        }
      };
      auto store_raw = [&]() {
#pragma unroll
        for (int i = 0; i < 2; ++i) {
          const int cid = t + 512 * i, row = cid >> 4, c = cid & 15;
          const int rw = dir ? 63 - row : row;
          *(u32x4*)((unsigned char*)RQ + rw * 256 + c * 16) = rq[i];
          *(u32x4*)((unsigned char*)RG + rw * 256 + c * 16) = rgv[i];
        }
      };
      auto store_v = [&]() {
#pragma unroll
        for (int i = 0; i < 2; ++i) {
          const int cid = t + 512 * i, vv = cid >> 3, c8 = cid & 7;
          const int cc = dir ? 7 - c8 : c8;
          *(u32x4*)(VT + vv * 128 + ((cc ^ ((vv >> 1) & 7)) << 4)) = dir ? rev8(rv[i]) : rv[i];
        }
      };
      __syncthreads();
      gload(0);
      store_raw();
      store_v();
      __syncthreads();
      for (int step = 0; step < 64; ++step) {
        const int cidx = dir ? 63 - step : step;
        const long tok0 = (long)b * 4096 + cidx * 64;
        if (step + 1 < 64) gload(step + 1);
        {
          float gvr[16];
          float psum = 0.f;
#pragma unroll
          for (int rr = 0; rr < 16; ++rr) { gvr[rr] = __half2float(RG[(qr * 16 + rr) * 128 + col]); psum += gvr[rr]; }
          PS[qr * 128 + col] = psum;
          __syncthreads();
          const float p0 = PS[col], p1 = PS[128 + col], p2 = PS[256 + col], p3 = PS[384 + col];
          const float tot = (p0 + p1) + (p2 + p3);
          const float pre = (qr > 0 ? p0 : 0.f) + (qr > 1 ? p1 : 0.f) + (qr > 2 ? p2 : 0.f);
          float eb = __expf(pre), ieb = __expf(-pre);
          const float etot = __expf(tot);
          unsigned khp[8];
#pragma unroll
          for (int rr = 0; rr < 16; ++rr) {
            const int r = qr * 16 + rr;
            const float f = __expf(gvr[rr]);
            eb *= f;
            ieb *= __builtin_amdgcn_rcpf(f);
            const float qv = bf2f(RQ[r * 128 + col]);
            const float kk = 1.f - f;
            const float kt = kk * ieb;
            const unsigned off = r * 256 + (((col >> 3) ^ (r & 15)) << 4) + (col & 7) * 2;
            *(u16*)(QT + off) = f2bf(qv * eb);
            *(u16*)(KT + off) = f2bf(kt);
            const float kh = kt * etot;
            if (rr & 1) khp[rr >> 1] = pack2(__uint_as_float(khp[rr >> 1]), kh); else khp[rr >> 1] = __float_as_uint(kh);
          }
          const int sw = (col >> 1) & 7;
          u32x4 k0, k1;
          k0.x = khp[0]; k0.y = khp[1]; k0.z = khp[2]; k0.w = khp[3];
          k1.x = khp[4]; k1.y = khp[5]; k1.z = khp[6]; k1.w = khp[7];
          *(u32x4*)(KH + col * 128 + (((qr * 2) ^ sw) << 4)) = k0;
          *(u32x4*)(KH + col * 128 + (((qr * 2 + 1) ^ sw) << 4)) = k1;
          if (qr == 0) DEC[col] = etot;
        }
        __syncthreads();
        if (step + 1 < 64) store_raw();
        __builtin_amdgcn_sched_barrier(0);
        bf16x8 Sop[4];
#pragma unroll
        for (int i = 0; i < 4; ++i) Sop[i] = pack8(S[2 * i], S[2 * i + 1]);
        f32x4 ot[4];
#pragma unroll
        for (int tt = 0; tt < 4; ++tt) {
          const unsigned char* qrow = QT + (tt * 16 + lq) * 256;
          bf16x8 qB[4];
#pragma unroll
          for (int ks = 0; ks < 4; ++ks) qB[ks] = *(const bf16x8*)(qrow + (((ks * 4 + lg) ^ lq) << 4));
          f32x4 at[4];
#pragma unroll
          for (int st = 0; st < 4; ++st) {
            at[st] = f32x4{0.f, 0.f, 0.f, 0.f};
            if (st <= tt) {
              const unsigned char* krow = KT + (st * 16 + lq) * 256;
#pragma unroll
              for (int ks = 0; ks < 4; ++ks) {
                const bf16x8 kA = *(const bf16x8*)(krow + (((ks * 4 + lg) ^ lq) << 4));
                at[st] = MFMA16(kA, qB[ks], at[st]);
              }
              if (st == tt) {
#pragma unroll
                for (int rr = 0; rr < 4; ++rr) if (lg * 4 + rr > lq) at[st][rr] = 0.f;
              }
            }
          }
          f32x4 acc = f32x4{0.f, 0.f, 0.f, 0.f};
#pragma unroll
          for (int kk = 0; kk < 2; ++kk) {
            if (2 * kk <= tt) {
              const bf16x8 pfr = pack8(at[2 * kk], at[2 * kk + 1]);
              const unsigned char* vr = VT + (vs + lq) * 128 + (lg & 1) * 8;
              const s16x4 lo = *(const s16x4*)(vr + (((kk * 4 + (lg >> 1)) ^ vsw) << 4));
              const s16x4 hi = *(const s16x4*)(vr + (((kk * 4 + (lg >> 1) + 2) ^ vsw) << 4));
              acc = MFMA16(cat8(lo, hi), pfr, acc);
            }
          }
#pragma unroll
          for (int i = 0; i < 4; ++i) {
            const unsigned char* qr8 = qrow + (lg & 1) * 8;
            const s16x4 lo = *(const s16x4*)(qr8 + (((i * 4 + (lg >> 1)) ^ lq) << 4));
            const s16x4 hi = *(const s16x4*)(qr8 + (((i * 4 + (lg >> 1) + 2) ^ lq) << 4));
            acc = MFMA16(Sop[i], cat8(lo, hi), acc);
          }
          ot[tt] = acc;
          __builtin_amdgcn_sched_barrier(0);
        }
#pragma unroll
        for (int ct = 0; ct < 8; ++ct) {
          const f32x4 dc = *(const f32x4*)(DEC + ct * 16 + lg * 4);
          f32x4 sn = S[ct] * dc;
#pragma unroll
          for (int kk = 0; kk < 2; ++kk) {
            const bf16x8 khA = *(const bf16x8*)(KH + (ct * 16 + lq) * 128 + (((kk * 4 + lg) ^ vsw) << 4));
            const bf16x8 vB = *(const bf16x8*)(VT + (vs + lq) * 128 + (((kk * 4 + lg) ^ vsw) << 4));
            sn = MFMA16(khA, vB, sn);
          }
          S[ct] = sn;
          if (ct & 1) __builtin_amdgcn_sched_barrier(0);
        }
        if (dir == 0) {
#pragma unroll
          for (int tt = 0; tt < 4; ++tt) {
            const long off = (tok0 + tt * 16 + lq) * 1024 + h * 128 + vs + lg * 4;
            *(u32x2*)(o + off) = pack4(ot[tt][0], ot[tt][1], ot[tt][2], ot[tt][3]);
          }
        } else {
#pragma unroll
          for (int tt = 0; tt < 4; ++tt) {
            const long off = (tok0 + 63 - (tt * 16 + lq)) * 1024 + h * 128 + vs + lg * 4;
            const u32x2 pv = *(const u32x2*)(o + off);
            ot[tt][0] += bflo(pv.x); ot[tt][1] += bfhi(pv.x); ot[tt][2] += bflo(pv.y); ot[tt][3] += bfhi(pv.y);
            float sq = ot[tt][0] * ot[tt][0] + ot[tt][1] * ot[tt][1] + ot[tt][2] * ot[tt][2] + ot[tt][3] * ot[tt][3];
            sq += __shfl_xor(sq, 16);
            sq += __shfl_xor(sq, 32);
            if (lg == 0) RED[w * 64 + tt * 16 + lq] = sq;
          }
          __syncthreads();
          const float4 gv = *(const float4*)(g_out + h * 128 + vs + lg * 4);
#pragma unroll
          for (int tt = 0; tt < 4; ++tt) {
            float sq = 0.f;
#pragma unroll
            for (int ww = 0; ww < 8; ++ww) sq += RED[ww * 64 + tt * 16 + lq];
            const float rs = rsqrtf(sq * (1.f / 128.f) + 1e-6f);
            const long off = (tok0 + 63 - (tt * 16 + lq)) * 1024 + h * 128 + vs + lg * 4;
            *(u32x2*)(o + off) = pack4(ot[tt][0] * rs * gv.x, ot[tt][1] * rs * gv.y, ot[tt][2] * rs * gv.z, ot[tt][3] * rs * gv.w);
          }
        }
        __syncthreads();
        if (step + 1 < 64) store_v();
      }
    }
  }
}

DI void final_norm(const Params& p) {
  const int tt_ = tid_opaque();
  const int l = tt_ & 63, gw = blockIdx.x * 8 + (tt_ >> 6), nw = gridDim.x * 8;
  for (int row = gw; row < T_TOK; row += nw) {
    float4* xp = (float4*)(p.out + (long)row * 1024);
    float4 v[4];
    float s = 0.f;
#pragma unroll
    for (int i = 0; i < 4; ++i) {
      v[i] = xp[l + 64 * i];
      s += v[i].x * v[i].x + v[i].y * v[i].y + v[i].z * v[i].z + v[i].w * v[i].w;
    }
#pragma unroll
    for (int o = 1; o < 64; o <<= 1) s += __shfl_xor(s, o);
    const float rs = rsqrtf(s * (1.f / 1024.f) + 1e-6f);
#pragma unroll
    for (int i = 0; i < 4; ++i) {
      const float4 g = ((const float4*)p.final_g)[l + 64 * i];
      v[i].x *= rs * g.x; v[i].y *= rs * g.y; v[i].z *= rs * g.z; v[i].w *= rs * g.w;
      { const f32x4 ov_ = {v[i].x, v[i].y, v[i].z, v[i].w}; __builtin_nontemporal_store(ov_, (f32x4*)(xp + l + 64 * i)); }
    }
  }
}

struct GSync { unsigned* bar; unsigned k; };
DI void gsync(GSync& gs) { cg::this_grid().sync(); }

DI void run_out_ple(const Params& p, GSync& gs, int li, u16* og, u16* x1b, u16* xb_out, const u16* Wout, unsigned char* smem) {
  GP g{};
  g.A = og; g.lda = 1024; g.W = Wout; g.K = 1024; g.ntn = 4; g.ntiles = 320 * 4; g.d0 = x1b; g.li = li;
  gemm_phase<M_OUT>(p, g, smem);
  convert_p(p, li, (u16*)p.proj);
  gsync(gs);
  GP g2{};
  g2.A = x1b; g2.lda = 1024; g2.W = p.Wg + (long)li * 1024 * 1024; g2.K = 1024; g2.ntn = 4; g2.ntiles = 320 * 4;
  g2.d0 = xb_out; g2.d1 = p.proj; g2.ssq_out = p.ssq + (long)(li + 1) * T_TOK; g2.W2 = p.Wp + (long)li * 1024 * 256; g2.li = li;
  gemm_phase<M_PLE>(p, g2, smem);
  gsync(gs);
}

__global__ void __launch_bounds__(NTHR) fwd_megakernel(Params p) {
  __shared__ __attribute__((aligned(16))) unsigned char smem[SMEM_BYTES];
  cg::grid_group grid = cg::this_grid();
  GSync gs{p.bar, 0u};
  if ((PH_MASK >> 13) & 1u) {
  prep_rows(p);
  prep_transposes(p, smem);
  prep_misc(p, smem);
  }
  grid.sync();
  if ((PH_MASK >> 13) & 1u) prep_wprime(p);
  gsync(gs);
  unsigned char* P = p.proj;
  {
    GP g{};
    g.A = p.buf0; g.lda = 1024; g.W = p.Wfn; g.K = 1024; g.ntn = 12; g.ntiles = 320 * 12;
    g.d0 = P; g.d1 = P + 2 * SL; g.ssq_in = p.ssq;
    gemm_phase<M_FN_IN>(p, g, smem);
    gsync(gs);
    GP f1{};
    f1.A = (const u16*)P; f1.W = (const u16*)(P + 3 * SL); f1.K = 128; f1.ntn = 1; f1.ntiles = 5120;
    f1.d0 = p.buf0; f1.d1 = (P + 3 * SL + 2 * 256 * 128 * 2);
    gemm_phase<M_FFT1>(p, f1, smem);
    gsync(gs);
    GP f3{};
    f3.A = p.buf0; f3.W = (const u16*)(P + 3 * SL) + 256 * 128; f3.K = 128; f3.ntn = 1; f3.ntiles = 5120;
    f3.d0 = P + SL; f3.d1 = P + 2 * SL;
    gemm_phase<M_FFT3>(p, f3, smem);
    gsync(gs);
    run_out_ple(p, gs, 0, (u16*)(P + SL), p.buf0, p.buf1, p.Wfn_out, smem);
  }
  {
    GP g{};
    g.A = p.buf1; g.lda = 1024; g.W = p.Wna; g.K = 1024; g.ntn = 16; g.ntiles = 320 * 16;
    g.d0 = P; g.d1 = P + SL; g.d2 = P + 2 * SL; g.d3 = P + 3 * SL; g.ssq_in = p.ssq + T_TOK;
    gemm_phase<M_NA_IN>(p, g, smem);
    gsync(gs);
    na_phase(p, (const u16*)P, (const u16*)(P + SL), (const u16*)(P + 2 * SL), (const u16*)(P + 3 * SL), p.buf0, smem);
    gsync(gs);
    run_out_ple(p, gs, 1, p.buf0, p.buf1, p.buf0, p.Wna_out, smem);
  }
  {
    u16* cq = p.buf1; u16* ckv = p.buf1 + (long)T_TOK * 384;
    u16* qo = (u16*)P; u16* kn = (u16*)(P + SL + SL / 2); u16* vt = (u16*)(P + 2 * SL + SL / 2); u16* kpe = (u16*)(P + 3 * SL + SL / 2);
    GP g{};
    g.A = p.buf0; g.lda = 1024; g.W = p.Wmla_in; g.K = 1024; g.ntn = 3; g.ntiles = 320 * 3;
    g.d0 = cq; g.d1 = ckv; g.d2 = kpe; g.ssq_in = p.ssq + 2L * T_TOK; g.ssq_out = p.ssq_q; g.ssq_out2 = p.ssq_kv;
    gemm_phase<M_MLA_IN>(p, g, smem);
    gsync(gs);
    GP u{};
    u.A = cq; u.lda = 384; u.W = p.Wuq; u.K = 384; u.ntn = 6; u.ntiles = 320 * 6; u.d0 = qo; u.ssq_in = p.ssq_q;
    gemm_phase<M_MLA_UQ>(p, u, smem);
    GP v{};
    v.A = ckv; v.lda = 256; v.W = p.Wukv; v.K = 256; v.ntn = 8; v.ntiles = 320 * 8; v.d0 = kn; v.d1 = vt; v.ssq_in = p.ssq_kv;
    gemm_phase<M_MLA_UKV>(p, v, smem);
    gsync(gs);
    mla_attn(qo, kn, kpe, vt, p.buf1, smem);
    gsync(gs);
    GP z{};
    z.A = p.buf0; z.lda = 1024; z.W = p.Wmla_z; z.K = 1024; z.ntn = 4; z.ntiles = 320 * 4; z.d0 = p.buf1; z.ssq_in = p.ssq + 2L * T_TOK;
    gemm_phase<M_ZPASS>(p, z, smem);
    gsync(gs);
    run_out_ple(p, gs, 2, p.buf1, p.buf0, p.buf1, p.Wmla_out, smem);
  }
  {
    GP g{};
    g.A = p.buf1; g.lda = 1024; g.W = p.Whg; g.K = 1024; g.ntn = 16; g.ntiles = 320 * 16;
    g.d0 = P; g.d1 = P + SL; g.d2 = P + 2 * SL; g.d3 = P + 3 * SL; g.ssq_in = p.ssq + 3L * T_TOK;
    gemm_phase<M_HG_IN>(p, g, smem);
    gsync(gs);
    hg_scan((const u16*)P, (const __half*)(P + SL), (const __half*)(P + 2 * SL), (const u16*)(P + 3 * SL), p.hg_g_out, p.buf0, smem);
    gsync(gs);
    GP z{};
    z.A = p.buf1; z.lda = 1024; z.W = p.Whg_z; z.K = 1024; z.ntn = 4; z.ntiles = 320 * 4; z.d0 = p.buf0; z.ssq_in = p.ssq + 3L * T_TOK;
    gemm_phase<M_ZPASS>(p, z, smem);
    gsync(gs);
    run_out_ple(p, gs, 3, p.buf0, p.buf1, p.buf0, p.Whg_out, smem);
  }
  final_norm(p);
}

extern "C" void kernel_launch(void* const* d_in, const int* in_sizes, int n_in, void* d_out, int out_size,
                              void* d_ws, size_t ws_size, hipStream_t stream) {
  static int grid_blocks = 0;
  if (!grid_blocks) {
    int dev = 0, cus = 0, per_cu = 0;
    hipGetDevice(&dev);
    hipDeviceGetAttribute(&cus, hipDeviceAttributeMultiprocessorCount, dev);
    hipOccupancyMaxActiveBlocksPerMultiprocessor(&per_cu, fwd_megakernel, NTHR, 0);
    if (per_cu < 1) per_cu = 1;
    if (per_cu > 1) per_cu = 1;
    grid_blocks = cus * per_cu;
  }
  Params p;
  memset(&p, 0, sizeof(p));
  const float* const* in = (const float* const*)d_in;
  p.x_prompt = in[0]; p.x_sample = in[1]; p.p_prompt = in[2]; p.p_sample = in[3]; p.norm_g = in[4];
  p.fn_w_in = in[5]; p.fn_w_mix = in[6]; p.na_rpb = in[9]; p.hg_lb_raw = in[18]; p.hg_g_out = in[19]; p.final_g = in[23];
  const float* fn_w_out = in[7]; const float* na_w_in = in[8]; const float* na_w_out = in[10];
  const float* mla_w_in = in[11]; const float* mla_g_q = in[12]; const float* mla_w_uq = in[13];
  const float* mla_g_kv = in[14]; const float* mla_w_ukv = in[15]; const float* mla_w_out = in[16];
  const float* hg_w_in = in[17]; const float* hg_w_out = in[20]; const float* ple_w = in[21]; const float* ple_gate_w = in[22];
  p.out = (float*)d_out;
  unsigned char* ws = (unsigned char*)d_ws;
  size_t off = 0;
  auto take = [&](size_t bytes) { unsigned char* r = ws + off; off += (bytes + 255) & ~(size_t)255; return r; };
  p.buf0 = (u16*)take(SL); p.buf1 = (u16*)take(SL); p.proj = take(4 * SL);
  p.Wfn = (u16*)take(3072L * 1024 * 2); p.Wfn_out = (u16*)take(1024L * 1024 * 2);
  p.Wna = (u16*)take(4096L * 1024 * 2); p.Wna_out = (u16*)take(1024L * 1024 * 2);
  p.Wmla_in = (u16*)take(768L * 1024 * 2); p.Wmla_z = (u16*)take(1024L * 1024 * 2);
  p.Wuq = (u16*)take(1536L * 384 * 2); p.Wukv = (u16*)take(2048L * 256 * 2); p.Wmla_out = (u16*)take(1024L * 1024 * 2);
  p.Whg = (u16*)take(4096L * 1024 * 2); p.Whg_z = (u16*)take(1024L * 1024 * 2); p.Whg_out = (u16*)take(1024L * 1024 * 2);
  p.Wp = (u16*)take(4L * 1024 * 256 * 2); p.Wg = (u16*)take(4L * 1024 * 1024 * 2);
  p.CW = (float*)take(8L * 128 * 256 * 4); p.rope = (float*)take(4096L * 32 * 2 * 4);
  p.ssq = (float*)take(5L * T_TOK * 4); p.ssq_q = (float*)take((long)T_TOK * 4); p.ssq_kv = (float*)take((long)T_TOK * 4);
  p.lb = (float*)take(2048 * 4);
  p.bar = (unsigned*)take(256);
  if (off > ws_size) { fprintf(stderr, "workspace too small: need %zu have %zu\n", off, ws_size); return; }
  int nj = 0, tiles = 0;
  auto job = [&](const float* src, const float* g, u16* dst, int ld, int col0, int K, int N, float scale) {
    TJob& j = p.jobs[nj++];
    j.src = src; j.g = g; j.dst = dst; j.ld = ld; j.col0 = col0; j.K = K; j.N = N; j.scale = scale; j.tile0 = tiles;
    tiles += (K / 64) * (N / 64);
  };
  const float* ng = p.norm_g;
  job(p.fn_w_in, ng, p.Wfn + 2048L * 1024, 2048, 1024, 1024, 1024, 1.f);
  job(fn_w_out, nullptr, p.Wfn_out, 1024, 0, 1024, 1024, 1.f);
  job(na_w_in, ng + 1024, p.Wna, 4096, 0, 1024, 1024, 0.17677669529663687f);
  job(na_w_in, ng + 1024, p.Wna + 1024L * 1024, 4096, 1024, 1024, 3072, 1.f);
  job(na_w_out, nullptr, p.Wna_out, 1024, 0, 1024, 1024, 1.f);
  job(mla_w_in, ng + 2048, p.Wmla_in, 1728, 0, 1024, 704, 1.f);
  job(mla_w_in, ng + 2048, p.Wmla_z, 1728, 704, 1024, 1024, 1.f);
  job(mla_w_uq, mla_g_q, p.Wuq, 1536, 0, 384, 1536, 0.07216878364870322f * 1.4426950408889634f);
  for (int h = 0; h < 8; ++h)
    for (int part = 0; part < 2; ++part)
      job(mla_w_ukv, mla_g_kv, p.Wukv + (long)(part * 1024 + h * 128) * 256, 2048, h * 256 + part * 128, 256, 128, 1.f);
  job(mla_w_out, nullptr, p.Wmla_out, 1024, 0, 1024, 1024, 1.f);
  job(hg_w_in, ng + 3072, p.Whg, 5120, 0, 1024, 4096, 1.f);
  job(hg_w_in, ng + 3072, p.Whg_z, 5120, 4096, 1024, 1024, 1.f);
  job(hg_w_out, nullptr, p.Whg_out, 1024, 0, 1024, 1024, 1.f);
  for (int li = 0; li < 4; ++li) job(ple_w + (long)li * 256 * 1024, nullptr, p.Wp + (long)li * 1024 * 256, 1024, 0, 256, 1024, 1.f);
  for (int li = 0; li < 4; ++li) job(ple_gate_w + (long)li * 1024 * 1024, nullptr, p.Wg + (long)li * 1024 * 1024, 1024, 0, 1024, 1024, 1.f);
  p.njobs = nj; p.ntjt = tiles;
  void* args[] = {&p};
  hipError_t e = hipLaunchCooperativeKernel((void*)fwd_megakernel, dim3(grid_blocks), dim3(NTHR), args, 0, stream);
  if (e != hipSuccess) fprintf(stderr, "cooperative launch failed: %s (grid %d)\n", hipGetErrorString(e), grid_blocks);
}
```
